# Optimizing an MI355X kernel written in HIP

```python
import math, functools
import jax, jax.numpy as jnp
from jax import lax
import numpy as np

D_MODEL = 2048
BATCH = 16
SEQ = 2048
DEPTH = 1
DEC_BATCH = 32
DEC_SEQ = 32
PAST_LEN = 2048

CHUNK = 64
GLA_HEADS = 4
GLA_QK = D_MODEL // 2
GLA_V = D_MODEL
GLA_DK = GLA_QK // GLA_HEADS
GLA_DV = GLA_V // GLA_HEADS
GLA_GATE_RANK = 16
GLA_TAU = 16.0
ATT_HEADS = 8
ATT_DH = 128
ATT_WIDTH = ATT_HEADS * ATT_DH
BAND_CHUNKS = 8
BAND_PAST = BAND_CHUNKS * CHUNK
REL_CLIP = 128
D_FF = ((8 * D_MODEL // 3 + 127) // 128) * 128
CONV_W = 3
DN_ALPHA = (2.0 * DEPTH) ** 0.25
DN_BETA = (8.0 * DEPTH) ** -0.25
LN_EPS = 1e-5
RMS_EPS = 1e-6
NEG_INF = -1e30
IN_SPLITS = (GLA_QK, GLA_QK, GLA_V, GLA_V, GLA_GATE_RANK, ATT_WIDTH, ATT_WIDTH, ATT_WIDTH, D_MODEL, D_MODEL)
IN_WIDTH = 2 * GLA_QK + 2 * GLA_V + GLA_GATE_RANK + 3 * ATT_WIDTH + 2 * D_MODEL

kernel_name = "hybrid_gla_chunkband_convffn_deepnorm_step"


def _split_in(z):
    offs = np.cumsum(np.array(IN_SPLITS))[:-1].tolist()
    return jnp.split(z, offs, axis=-1)


def _layer_norm(x, g, b):
    xf = x.astype(jnp.float32)
    mu = jnp.mean(xf, axis=-1, keepdims=True)
    var = jnp.mean(jnp.square(xf - mu), axis=-1, keepdims=True)
    return ((xf - mu) * lax.rsqrt(var + LN_EPS) * g + b).astype(x.dtype)


def _rel_bias(table, rel):
    return table[:, jnp.clip(rel, -REL_CLIP, REL_CLIP) + REL_CLIP].astype(jnp.float32)


def _gla_recurrence(q, k, v, log_a, s0):
    B, L, H, _ = q.shape
    blk = min(CHUNK, L)
    n = L // blk

    def to_blocks(t):
        return t.reshape(B, n, blk, H, t.shape[-1]).transpose(1, 0, 3, 2, 4)

    qb, kb, vb, ab = to_blocks(q), to_blocks(k), to_blocks(v), to_blocks(log_a)
    causal = jnp.tril(jnp.ones((blk, blk), dtype=bool))

    def step(s, inp):
        qc, kc, vc, ac = inp
        b = jnp.cumsum(ac, axis=-2)
        b_last = b[..., -1:, :]
        q_t = qc * jnp.exp(b)
        k_t = kc * jnp.exp(-b)
        att = jnp.where(causal, jnp.einsum('bhtk,bhsk->bhts', q_t, k_t), 0.0)
        o = jnp.einsum('bhts,bhsv->bhtv', att, vc) + jnp.einsum('bhtk,bhkv->bhtv', q_t, s)
        k_dec = kc * jnp.exp(b_last - b)
        s_new = jnp.exp(b_last[..., 0, :])[..., None] * s + jnp.einsum('bhsk,bhsv->bhkv', k_dec, vc)
        return s_new, o

    s_fin, ob = lax.scan(step, s0, (qb, kb, vb, ab))
    o = ob.transpose(1, 0, 3, 2, 4).reshape(B, L, H, v.shape[-1])
    return o, s_fin


def _band_attention_chunked(q, k, v, rel_table):
    B, S, H, D = q.shape
    nc = S // CHUNK
    nb = BAND_CHUNKS + 1
    shp = (B, nc, CHUNK, H, D)
    pad = jnp.zeros((B, BAND_CHUNKS, CHUNK, H, D), k.dtype)
    kc = jnp.concatenate([pad, k.reshape(shp)], axis=1)
    vc = jnp.concatenate([pad, v.reshape(shp)], axis=1)
    qc = q.reshape(shp)
    scores = jnp.concatenate(
        [jnp.einsum('bnqhd,bnkhd->bnhqk', qc, kc[:, o:o + nc], preferred_element_type=jnp.float32)
         for o in range(nb)], axis=-1)
    koff = jnp.arange(nb * CHUNK) - BAND_CHUNKS * CHUNK
    rel = jnp.arange(CHUNK)[:, None] - koff[None, :]
    scores = scores * (D ** -0.5) + _rel_bias(rel_table, rel)[None, None]
    valid = (jnp.arange(nc)[:, None] * CHUNK + koff[None, :]) >= 0
    scores = jnp.where(valid[None, :, None, None, :], scores, NEG_INF)
    p = jax.nn.softmax(scores, axis=-1).astype(v.dtype)
    out = jnp.einsum('bnhqk,bnkhd->bnqhd', p[..., :CHUNK], vc[:, 0:nc])
    for o in range(1, nb):
        out = out + jnp.einsum('bnhqk,bnkhd->bnqhd', p[..., o * CHUNK:(o + 1) * CHUNK], vc[:, o:o + nc])
    return out.reshape(B, S, H, D)


def _band_attention_step(q, k_all, v_all, rel_table):
    L = q.shape[1]
    n_past = k_all.shape[1] - L
    s = jnp.einsum('bqhd,bkhd->bhqk', q, k_all, preferred_element_type=jnp.float32) * (q.shape[-1] ** -0.5)
    rel = (n_past + jnp.arange(L))[:, None] - jnp.arange(n_past + L)[None, :]
    s = s + _rel_bias(rel_table, rel)[None]
    p = jax.nn.softmax(s, axis=-1).astype(v_all.dtype)
    return jnp.einsum('bhqk,bkhd->bqhd', p, v_all)


def _layer(x, past_k, past_v, s0, conv_prev, prm):
    (w_in, gla_gate_up, gla_gate_b, gla_norm_g, att_rel_bias, merge_b, w_br_gla, w_br_att, w_out,
     ln1_g, ln1_b, w_ffn_up, ffn_conv_w, ffn_conv_b, w_ffn_down, ln2_g, ln2_b) = prm
    f32 = jnp.float32
    B, L, _ = x.shape
    z = x @ w_in
    q_g, k_g, v_g, r_g, a_lo, q_a, k_a, v_a, m_g, m_a = _split_in(z)

    log_a = jax.nn.log_sigmoid((a_lo @ gla_gate_up + gla_gate_b).astype(f32)) / GLA_TAU
    hq = lambda t, d: t.reshape(B, L, GLA_HEADS, d).astype(f32)
    o_gla, s_fin = _gla_recurrence(hq(q_g, GLA_DK) * (GLA_DK ** -0.5), hq(k_g, GLA_DK), hq(v_g, GLA_DV),
                                   hq(log_a, GLA_DK), s0.astype(f32))
    o_gla = o_gla * lax.rsqrt(jnp.mean(jnp.square(o_gla), axis=-1, keepdims=True) + RMS_EPS)
    o_gla = (o_gla.reshape(B, L, GLA_V) * gla_norm_g).astype(x.dtype) * jax.nn.silu(r_g)

    ha = lambda t: t.reshape(B, L, ATT_HEADS, ATT_DH)
    q_a, k_a, v_a = ha(q_a), ha(k_a), ha(v_a)
    if past_k is None:
        o_att = _band_attention_chunked(q_a, k_a, v_a, att_rel_bias)
        keep = min(BAND_PAST, L)
        new_k, new_v = k_a[:, L - keep:], v_a[:, L - keep:]
    else:
        k_all = jnp.concatenate([past_k.astype(k_a.dtype), k_a], axis=1)
        v_all = jnp.concatenate([past_v.astype(v_a.dtype), v_a], axis=1)
        o_att = _band_attention_step(q_a, k_all, v_all, att_rel_bias)
        new_k, new_v = k_a, v_a
    o_att = o_att.reshape(B, L, ATT_WIDTH).astype(x.dtype)

    mix = (jax.nn.sigmoid(m_g + merge_b[0]) * (o_gla @ w_br_gla)
           + jax.nn.sigmoid(m_a + merge_b[1]) * (o_att @ w_br_att)) @ w_out
    h = _layer_norm(DN_ALPHA * x + mix, ln1_g, ln1_b)

    ug = h @ w_ffn_up
    u, g = ug[..., :D_FF], ug[..., D_FF:]
    u_ext = jnp.concatenate([conv_prev.astype(u.dtype), u], axis=1)
    uc = ffn_conv_b + u_ext[:, 0:L] * ffn_conv_w[0]
    for i in range(1, CONV_W):
        uc = uc + u_ext[:, i:i + L] * ffn_conv_w[i]
    ffn = (jax.nn.gelu(uc) * g) @ w_ffn_down
    y = _layer_norm(DN_ALPHA * h + ffn, ln2_g, ln2_b)
    return y, new_k, new_v, s_fin.astype(x.dtype), u_ext[:, -(CONV_W - 1):]


def setup_inputs(seed: int = 0) -> dict:
    key = jax.random.key(seed)
    ks = jax.random.split(key, 24)
    nrm = lambda k, shape, s: jax.random.normal(k, shape, jnp.float32) * s
    n_cache = min(BAND_PAST, PAST_LEN)
    return {
        "x_prompt": nrm(ks[0], (BATCH, SEQ, D_MODEL), 1.0),
        "x_sample": nrm(ks[1], (DEC_BATCH, DEC_SEQ, D_MODEL), 1.0),
        "cache_att_k": nrm(ks[2], (DEPTH, DEC_BATCH, n_cache, ATT_HEADS, ATT_DH), 1.0),
        "cache_att_v": nrm(ks[3], (DEPTH, DEC_BATCH, n_cache, ATT_HEADS, ATT_DH), 1.0),
        "state_gla": nrm(ks[4], (DEPTH, DEC_BATCH, GLA_HEADS, GLA_DK, GLA_DV), 0.5),
        "state_ffn_conv": nrm(ks[5], (DEPTH, DEC_BATCH, CONV_W - 1, D_FF), 1.0),
        "w_in": nrm(ks[6], (DEPTH, D_MODEL, IN_WIDTH), D_MODEL ** -0.5),
        "gla_gate_up": nrm(ks[7], (DEPTH, GLA_GATE_RANK, GLA_QK), GLA_GATE_RANK ** -0.5),
        "gla_gate_b": nrm(ks[8], (DEPTH, GLA_QK), 0.1),
        "gla_norm_g": 1.0 + nrm(ks[9], (DEPTH, GLA_V), 0.05),
        "att_rel_bias": nrm(ks[10], (DEPTH, ATT_HEADS, 2 * REL_CLIP + 1), 0.1),
        "merge_b": nrm(ks[11], (DEPTH, 2, D_MODEL), 0.1),
        "w_br_gla": nrm(ks[12], (DEPTH, GLA_V, D_MODEL), GLA_V ** -0.5),
        "w_br_att": nrm(ks[13], (DEPTH, ATT_WIDTH, D_MODEL), ATT_WIDTH ** -0.5),
        "w_out": nrm(ks[14], (DEPTH, D_MODEL, D_MODEL), DN_BETA * D_MODEL ** -0.5),
        "ln1_g": 1.0 + nrm(ks[15], (DEPTH, D_MODEL), 0.05),
        "ln1_b": nrm(ks[16], (DEPTH, D_MODEL), 0.02),
        "w_ffn_up": nrm(ks[17], (DEPTH, D_MODEL, 2 * D_FF), D_MODEL ** -0.5),
        "ffn_conv_w": nrm(ks[18], (DEPTH, CONV_W, D_FF), CONV_W ** -0.5),
        "ffn_conv_b": nrm(ks[19], (DEPTH, D_FF), 0.02),
        "w_ffn_down": nrm(ks[20], (DEPTH, D_FF, D_MODEL), DN_BETA * D_FF ** -0.5),
        "ln2_g": 1.0 + nrm(ks[21], (DEPTH, D_MODEL), 0.05),
        "ln2_b": nrm(ks[22], (DEPTH, D_MODEL), 0.02),
    }


def reference(x_prompt, x_sample, cache_att_k, cache_att_v, state_gla, state_ffn_conv,
              w_in, gla_gate_up, gla_gate_b, gla_norm_g, att_rel_bias, merge_b,
              w_br_gla, w_br_att, w_out, ln1_g, ln1_b, w_ffn_up, ffn_conv_w, ffn_conv_b,
              w_ffn_down, ln2_g, ln2_b):
    xp, xs = x_prompt, x_sample
    bp = xp.shape[0]
    kp, vp, sp, cp = [], [], [], []
    ksm, vsm, ssm, csm = [], [], [], []
    for l in range(DEPTH):
        prm = (w_in[l], gla_gate_up[l], gla_gate_b[l], gla_norm_g[l], att_rel_bias[l], merge_b[l],
               w_br_gla[l], w_br_att[l], w_out[l], ln1_g[l], ln1_b[l], w_ffn_up[l], ffn_conv_w[l],
               ffn_conv_b[l], w_ffn_down[l], ln2_g[l], ln2_b[l])
        s0_p = jnp.zeros((bp, GLA_HEADS, GLA_DK, GLA_DV), jnp.float32)
        conv0_p = jnp.zeros((bp, CONV_W - 1, D_FF), xp.dtype)
        xp, k1, v1, s1, c1 = _layer(xp, None, None, s0_p, conv0_p, prm)
        kp.append(k1); vp.append(v1); sp.append(s1); cp.append(c1)
        xs, k2, v2, s2, c2 = _layer(xs, cache_att_k[l], cache_att_v[l], state_gla[l], state_ffn_conv[l], prm)
        ksm.append(k2); vsm.append(v2); ssm.append(s2); csm.append(c2)
    return (xp, xs,
            jnp.stack(kp), jnp.stack(vp), jnp.stack(sp), jnp.stack(cp),
            jnp.stack(ksm), jnp.stack(vsm), jnp.stack(ssm), jnp.stack(csm))
```

```cpp
#include <hip/hip_runtime.h>
#include <hip/hip_cooperative_groups.h>
#include <cstdio>
namespace cg = cooperative_groups;
namespace pg8 {
#define PG8_LAS __attribute__((address_space(3)))
typedef unsigned short bf16_t;
typedef short bf16x8 __attribute__((ext_vector_type(8)));
typedef float f32x4 __attribute__((ext_vector_type(4)));
typedef unsigned u32x4 __attribute__((ext_vector_type(4)));
constexpr int BM = 256, BK = 64, HALF = 128, HTB = HALF * BK * 2  , STAGE_BYTES = 8 * HTB, NXCD = 8, WGM = 8;

__host__ __device__ __forceinline__ int lds_byte(int r, int c) { const int st = (r >> 4) * 2 + (c >> 5), rr = r & 15, cc = c & 31, ob = rr * 64 + cc * 2; return st * 1024 + (ob ^ (((ob >> 9) & 1) << 5)); }
__host__ __device__ __forceinline__ void stage_rc(int b, int& R, int& C) { const int st = b / 1024, sb = b % 1024, swz = sb ^ (((sb >> 9) & 1) << 5); R = (st >> 1) * 16 + swz / 64; C = (st & 1) * 32 + (swz % 64) / 2; }
__host__ __device__ __forceinline__ int perm32(int rho) { const int n = rho >> 4, i = rho & 15; return 8 * (i >> 2) + 4 * n + (i & 3); }

struct Unit { int pm, pn; };
struct Gemm { const bf16_t* A; const bf16_t* Bt; int M, N, K; };

struct StaticOrder {
    int nM, nN, nwg, G, c;
    __host__ __device__ void init(int M, int N, int G_, int c_) { nM = M / BM; nN = N / BM; nwg = nM * nN; G = G_; c = c_; }
    __host__ __device__ bool next(int i, Unit& u) const {
        const long L = (long)i * G + c; if (L >= nwg) return false;
        int wgid = (int)L; { const int q = nwg / NXCD, r = nwg % NXCD, xcd = wgid % NXCD, off = wgid / NXCD; wgid = (xcd < r ? xcd * (q + 1) : r * (q + 1) + (xcd - r) * q) + off; }
        const int nig = WGM * nN, gid = wgid / nig, fm = gid * WGM, gsz = (nM - fm) < WGM ? (nM - fm) : WGM;
        u.pm = fm + ((wgid % nig) % gsz); u.pn = (wgid % nig) / gsz; return true;
    }
    __device__ __forceinline__ void a_ready(const Unit&) const {}
    __device__ __forceinline__ void done(const Unit&) const {}
};
typedef float f32x2_c __attribute__((ext_vector_type(2))); typedef __bf16 bf16x2_c __attribute__((ext_vector_type(2)));
__device__ __forceinline__ unsigned cvt_pk_bf16(float lo, float hi) { const f32x2_c v = {lo, hi}; return __builtin_bit_cast(unsigned, __builtin_convertvector(v, bf16x2_c)); }
template <class Epi, class Sched, bool STAMP = false>
__device__ __forceinline__ void gemm_phase(PG8_LAS unsigned char* lds, const Gemm g, const Sched& S, const Epi& E, unsigned long long* stamps) {
    int tid = threadIdx.x; asm volatile("" : "+v"(tid)); const int wid = __builtin_amdgcn_readfirstlane(tid >> 6), lane = tid & 63, wr = wid >> 2, wc = wid & 3, fr = lane & 15, fq = lane >> 4;
    const int K = g.K, nt = K / BK;
    int ts_lo = 0, ts_hi = 0, nts = 0; const unsigned long long rt_entry = STAMP ? (unsigned long long)wall_clock64() : 0ull;
#define PG8_STAMP() do { if (STAMP && wid == 0 && nts < 64) { const unsigned long long _c = (unsigned long long)clock64(); \
        ts_lo = (lane == nts) ? (int)(unsigned)_c : ts_lo; ts_hi = (lane == nts) ? (int)(unsigned)(_c >> 32) : ts_hi; ++nts; } } while (0)
    PG8_STAMP();
    unsigned voffA[2], voffB[2];
#pragma unroll
    for (int i = 0; i < 2; ++i) { int R, C; stage_rc(tid * 16 + i * 8192, R, C); const int Rb = Epi::PERM ? ((R & ~31) + perm32(R & 31)) : R;
        voffA[i] = (unsigned)(R * K + C) * 2u; voffB[i] = (unsigned)(Rb * K + C) * 2u; }
    const size_t kstep = (size_t)(BK * 2);
    const size_t hstep = (size_t)HALF * K * 2;
    const size_t tstep = 2 * hstep;
    const unsigned ldsw = (unsigned)wid * 1024u;
    const int aoff = lds_byte(wr * 64 + fr, fq * 8), boff = lds_byte(wc * 32 + fr, fq * 8);
#define PG8_SA(b, h) (((b) * 2 + (h)) * HTB)
#define PG8_SB(b, h) ((4 + (b) * 2 + (h)) * HTB)
#define PG8_STAGE(bufoff, gbase, voff) do { _Pragma("unroll") for (int _i = 0; _i < 2; ++_i) \
        __builtin_amdgcn_global_load_lds((const unsigned*)((const char*)(gbase) + (voff)[_i]), (PG8_LAS unsigned*)(lds + (bufoff) + ldsw + _i * 8192), 16, 0, 0); } while (0)
#define PG8_LDA(dst, b, h) do { _Pragma("unroll") for (int m = 0; m < 4; ++m) _Pragma("unroll") for (int k = 0; k < 2; ++k) dst[m][k] = *(const PG8_LAS bf16x8*)(lds + PG8_SA(b, h) + aoff + m * 2048 + k * 1024); } while (0)
#define PG8_LDB(dst, b, h) do { _Pragma("unroll") for (int n = 0; n < 2; ++n) _Pragma("unroll") for (int k = 0; k < 2; ++k) dst[n][k] = *(const PG8_LAS bf16x8*)(lds + PG8_SB(b, h) + boff + n * 2048 + k * 1024); } while (0)
#define PG8_MMA(ai, bj, At, Bt) do { __builtin_amdgcn_s_setprio(1); _Pragma("unroll") for (int m = 0; m < 4; ++m) _Pragma("unroll") for (int n = 0; n < 2; ++n) _Pragma("unroll") for (int k = 0; k < 2; ++k) \
        acc[ai][bj][m][n] = __builtin_amdgcn_mfma_f32_16x16x32_bf16(Bt[n][k], At[m][k], acc[ai][bj][m][n], 0, 0, 0); __builtin_amdgcn_s_setprio(0); } while (0)
#define PG8_WAIT_V(n) asm volatile("s_waitcnt vmcnt(" #n ")" ::: "memory")
#define PG8_WAIT_L(n) asm volatile("s_waitcnt lgkmcnt(" #n ")" ::: "memory")
#define PG8_BAR __builtin_amdgcn_s_barrier()
#define PG8_SCHED __builtin_amdgcn_sched_barrier(0)
    Unit cur, nxt; int ui = 0;
    if (!S.next(0, cur)) return;
    f32x4 acc[2][2][4][2];
#pragma unroll
    for (int a = 0; a < 2; ++a)
#pragma unroll
        for (int b = 0; b < 2; ++b)
#pragma unroll
            for (int m = 0; m < 4; ++m)
#pragma unroll
                for (int n = 0; n < 2; ++n) acc[a][b][m][n] = (f32x4){0.f, 0.f, 0.f, 0.f};
    bf16x8 At[4][2], B0[2][2], B1[2][2];
    const char* cA = (const char*)g.A + (size_t)cur.pm * tstep; const char* cB = (const char*)g.Bt + (size_t)cur.pn * tstep;
    S.a_ready(cur);
    PG8_STAGE(PG8_SB(0, 0), cB, voffB); PG8_STAGE(PG8_SA(0, 0), cA, voffA); PG8_STAGE(PG8_SB(0, 1), cB + hstep, voffB); PG8_STAGE(PG8_SA(0, 1), cA + hstep, voffA);
    if (wr == 1) PG8_BAR;
    PG8_WAIT_V(4); PG8_BAR;
    PG8_STAGE(PG8_SB(1, 0), cB + kstep, voffB); PG8_STAGE(PG8_SA(1, 0), cA + kstep, voffA); PG8_STAGE(PG8_SB(1, 1), cB + hstep + kstep, voffB);
    PG8_WAIT_V(6); PG8_BAR;
    PG8_STAMP();
    for (;;) {
        const bool has_next = S.next(ui + 1, nxt);
        const char* nA = has_next ? (const char*)g.A + (size_t)nxt.pm * tstep : cA; const char* nB = has_next ? (const char*)g.Bt + (size_t)nxt.pn * tstep : cB;
        for (int t = 0; t < nt; t += 2) {
            const bool last = (t == nt - 2);
            const char* a1 = cA + (size_t)(t + 1) * kstep;
            const char* a2 = last ? nA : cA + (size_t)(t + 2) * kstep; const char* b2 = last ? nB : cB + (size_t)(t + 2) * kstep;
            const char* a3 = a2 + kstep; const char* b3 = b2 + kstep;
            if (last && has_next) S.a_ready(nxt);
            PG8_LDB(B0, 0, 0); PG8_SCHED; PG8_LDA(At, 0, 0); PG8_STAGE(PG8_SA(1, 1), a1 + hstep, voffA);
            PG8_WAIT_L(8); PG8_BAR; PG8_WAIT_L(0); PG8_MMA(0, 0, At, B0); PG8_BAR; PG8_SCHED;
            PG8_LDB(B1, 0, 1); PG8_STAGE(PG8_SB(0, 0), b2, voffB);
            PG8_BAR; PG8_WAIT_L(0); PG8_MMA(0, 1, At, B1); PG8_BAR;
            PG8_LDA(At, 0, 1); PG8_STAGE(PG8_SA(0, 0), a2, voffA);
            PG8_BAR; PG8_WAIT_L(0); PG8_MMA(1, 0, At, B0); PG8_BAR; PG8_SCHED;
            PG8_STAGE(PG8_SB(0, 1), b2 + hstep, voffB);
            PG8_WAIT_V(6); PG8_BAR; PG8_MMA(1, 1, At, B1); PG8_BAR;
            PG8_LDB(B0, 1, 0); PG8_SCHED; PG8_LDA(At, 1, 0); PG8_STAGE(PG8_SA(0, 1), a2 + hstep, voffA);
            PG8_WAIT_L(8); PG8_BAR; PG8_WAIT_L(0); PG8_MMA(0, 0, At, B0); PG8_BAR; PG8_SCHED;
            PG8_LDB(B1, 1, 1); PG8_STAGE(PG8_SB(1, 0), b3, voffB);
            PG8_BAR; PG8_WAIT_L(0); PG8_MMA(0, 1, At, B1); PG8_BAR;
            PG8_LDA(At, 1, 1); PG8_STAGE(PG8_SA(1, 0), a3, voffA);
            PG8_BAR; PG8_WAIT_L(0); PG8_MMA(1, 0, At, B0); PG8_BAR; PG8_SCHED;
            PG8_STAGE(PG8_SB(1, 1), b3 + hstep, voffB);
            PG8_WAIT_V(6); PG8_BAR; PG8_MMA(1, 1, At, B1); PG8_BAR;
        }
        PG8_STAMP();
        if constexpr (!Epi::AFTER_DRAIN) { E(acc, cur, wr, wc, fr, fq); S.done(cur); }
        PG8_STAMP();
        if (!has_next) break;
#pragma unroll
        for (int a = 0; a < 2; ++a)
#pragma unroll
            for (int b = 0; b < 2; ++b)
#pragma unroll
                for (int m = 0; m < 4; ++m)
#pragma unroll
                    for (int n = 0; n < 2; ++n) acc[a][b][m][n] = (f32x4){0.f, 0.f, 0.f, 0.f};
        cur = nxt; cA = nA; cB = nB; ++ui;
    }
    PG8_WAIT_V(0);
    if (wr == 0) PG8_BAR;
    PG8_BAR;
    if constexpr (Epi::AFTER_DRAIN) { E.fused(acc, cur, wr, wc, fr, fq, lds, wid, lane); S.done(cur); }
    PG8_STAMP();
    if (STAMP && wid == 0) { stamps[lane] = lane < nts ? (((unsigned long long)(unsigned)ts_hi << 32) | (unsigned)ts_lo) : 0ull;
        if (lane == 62) stamps[62] = rt_entry; if (lane == 63) stamps[63] = (unsigned long long)wall_clock64(); }
#undef PG8_STAMP
#undef PG8_SA
#undef PG8_SB
#undef PG8_STAGE
#undef PG8_LDA
#undef PG8_LDB
#undef PG8_MMA
#undef PG8_WAIT_V
#undef PG8_WAIT_L
#undef PG8_BAR
#undef PG8_SCHED
}
}

#define LAS PG8_LAS
using pg8::bf16x8; using pg8::f32x4; using pg8::u32x4; using pg8::Unit; using pg8::cvt_pk_bf16;
typedef unsigned short u16;
typedef unsigned u32x2 __attribute__((ext_vector_type(2)));

constexpr int M = 33792, MP = 32768, DM = 2048, DFF = 5504, ZN = 13568, NUP = 11008;
constexpr int LDS_BYTES = 147456;
constexpr float DN_ALPHA = 1.189207115002721f;
constexpr size_t O_Y = 0, O_KP = 69206016, O_VP = 77594624, O_SP = 85983232, O_CP = 94371840, O_KS = 94547968, O_VS = 95596544, O_SS = 96645120, O_CS = 113422336;
constexpr size_t SZ_R1 = (size_t)M * 1024 * 2, SZ_R2 = (size_t)M * 2048 * 2;
constexpr size_t W_IN = 0, W_BRG = W_IN + (size_t)ZN * 2048 * 2, W_BRA = W_BRG + (size_t)2048 * 2048 * 2, W_OUT = W_BRA + (size_t)2048 * 1024 * 2,
                 W_UP = W_OUT + (size_t)2048 * 2048 * 2, W_DN = W_UP + (size_t)NUP * 2048 * 2, W_END = W_DN + (size_t)2048 * DFF * 2;
constexpr size_t R_QG = W_END, R_KG = R_QG + SZ_R1, R_VG = R_KG + SZ_R1, R_RG = R_VG + SZ_R2, R_QA = R_RG + SZ_R2, R_KA = R_QA + SZ_R1, R_VAT = R_KA + SZ_R1,
                 R_MG = R_VAT + (size_t)16 * 8 * 128 * 2048 * 2, R_MA = R_MG + SZ_R2, R_ALO = R_MA + SZ_R2, WS_END = R_ALO + (size_t)M * 16 * 4;
constexpr size_t R_T1 = R_QG, R_T = R_RG, R_HB = R_QG, R_SIDE = R_VG, R_AACT = R_RG;
constexpr int NSEG = M / 64;
constexpr size_t SZ_SIDE = (size_t)NSEG * 2 * DFF * 4;

struct Params {
    const float *x_prompt, *x_sample, *cache_k, *cache_v, *state_gla, *state_conv, *w_in, *gate_up, *gate_b, *norm_g, *rel_bias, *merge_b, *w_brg, *w_bra, *w_out,
        *ln1_g, *ln1_b, *w_up, *conv_w, *conv_b, *w_dn, *ln2_g, *ln2_b;
    float* out; unsigned char* ws;
};

__device__ __forceinline__ int opaque_tid() { int t = threadIdx.x; asm volatile("" : "+v"(t)); return t; }
__device__ __forceinline__ float bf_lo(unsigned w) { return __uint_as_float(w << 16); }
__device__ __forceinline__ float bf_hi(unsigned w) { return __uint_as_float(w & 0xffff0000u); }
__device__ __forceinline__ bf16x8 as_bf8(u32x4 v) { return __builtin_bit_cast(bf16x8, v); }
__device__ __forceinline__ f32x4 mfma16(bf16x8 a, bf16x8 b, f32x4 c) { return __builtin_amdgcn_mfma_f32_16x16x32_bf16(a, b, c, 0, 0, 0); }
__device__ __forceinline__ u16 f2bf(float f) { return (u16)(cvt_pk_bf16(f, 0.f) & 0xffffu); }
__device__ __forceinline__ float sigmoidf_(float x) { return 1.f / (1.f + __expf(-x)); }
__device__ __forceinline__ float gelu_tanh(float x) { const float t = 1.5957691216057308f * (x + 0.044715f * x * x * x); return x / (1.f + __expf(-t)); }
__device__ __forceinline__ float wave_sum(float v) {
#pragma unroll
    for (int o = 1; o < 64; o <<= 1) v += __shfl_xor(v, o);
    return v;
}
__device__ __forceinline__ u32x4 pack8(f32x4 a, f32x4 b) { u32x4 w; w.x = cvt_pk_bf16(a[0], a[1]); w.y = cvt_pk_bf16(a[2], a[3]); w.z = cvt_pk_bf16(b[0], b[1]); w.w = cvt_pk_bf16(b[2], b[3]); return w; }

template <class Map>
__device__ __forceinline__ void transpose_mat(const float* W, int K, int Nsrc, u16* WT, int Ndst, Map map, LAS float* scr, int gw, int NGW, int lane) {
    const int nblk = Ndst / 32, nitems = (K / 64) * nblk;
    for (int it = gw; it < nitems; it += NGW) {
        const int kb = it / nblk, nb = it % nblk, k0 = 64 * kb, n0 = 32 * nb;
        const int sc = map(n0 + (lane & 31));
#pragma unroll 8
        for (int i = 0; i < 32; ++i) { const int kk = 2 * i + (lane >> 5); scr[kk * 33 + (lane & 31)] = sc >= 0 ? W[(size_t)(k0 + kk) * Nsrc + sc] : 0.f; }
        __builtin_amdgcn_wave_barrier();
        const int c = lane & 7;
#pragma unroll
        for (int j = 0; j < 4; ++j) { const int n = (lane >> 3) + 8 * j; const LAS float* s = scr + (8 * c) * 33 + n;
            u32x4 o; o.x = cvt_pk_bf16(s[0 * 33], s[1 * 33]); o.y = cvt_pk_bf16(s[2 * 33], s[3 * 33]); o.z = cvt_pk_bf16(s[4 * 33], s[5 * 33]); o.w = cvt_pk_bf16(s[6 * 33], s[7 * 33]);
            *(u32x4*)(WT + (size_t)(n0 + n) * K + k0 + 8 * c) = o; }
        __builtin_amdgcn_wave_barrier();
    }
}
struct MapId { __device__ __forceinline__ int operator()(int n) const { return n; } };
struct MapIn { __device__ __forceinline__ int operator()(int n) const { return n < 6144 ? n : (n < 13312 ? n + 16 : (n < 13328 ? n - 13312 + 6144 : -1)); } };
struct MapUp { __device__ __forceinline__ int operator()(int n) const { const int pn = n >> 8, j = n & 255; return j < 128 ? 128 * pn + j : DFF + 128 * pn + (j - 128); } };

__device__ __forceinline__ void phase0(LAS unsigned char* lds, const Params& p) {
    const int tid = opaque_tid(), lane = tid & 63, w = tid >> 6;
    const int gw = blockIdx.x * 8 + w, NGW = gridDim.x * 8;
    LAS float* scr = (LAS float*)(lds + w * 8704);
    transpose_mat(p.w_in, 2048, 13328, (u16*)(p.ws + W_IN), ZN, MapIn(), scr, gw, NGW, lane);
    transpose_mat(p.w_brg, 2048, 2048, (u16*)(p.ws + W_BRG), 2048, MapId(), scr, gw, NGW, lane);
    transpose_mat(p.w_bra, 1024, 2048, (u16*)(p.ws + W_BRA), 2048, MapId(), scr, gw, NGW, lane);
    transpose_mat(p.w_out, 2048, 2048, (u16*)(p.ws + W_OUT), 2048, MapId(), scr, gw, NGW, lane);
    transpose_mat(p.w_up, 2048, NUP, (u16*)(p.ws + W_UP), NUP, MapUp(), scr, gw, NGW, lane);
    transpose_mat(p.w_dn, DFF, 2048, (u16*)(p.ws + W_DN), 2048, MapId(), scr, gw, NGW, lane);
    u16* xb = (u16*)p.out;
    const size_t n8 = (size_t)M * DM / 8, np8 = (size_t)MP * DM / 8;
    for (size_t i = (size_t)blockIdx.x * 512 + tid; i < n8; i += (size_t)gridDim.x * 512) {
        const float* s = i < np8 ? p.x_prompt + i * 8 : p.x_sample + (i - np8) * 8;
        const f32x4 a = *(const f32x4*)s, b = *(const f32x4*)(s + 4);
        *(u32x4*)(xb + i * 8) = pack8(a, b);
    }
}

struct EpiZ {
    static constexpr bool PERM = true, AFTER_DRAIN = false;
    unsigned char* ws; float* out; const float* merge_b;
    __device__ __forceinline__ void operator()(const f32x4 (&acc)[2][2][4][2], const Unit& u, int wr, int wc, int fr, int fq) const {
        const int pn = u.pn, row0 = u.pm * 256 + wr * 64 + fr, colt = wc * 32 + 8 * fq;
        if (pn < 28 || (pn >= 36 && pn < 52)) {
            u16* base; int ld, c0; const float* bias = nullptr;
            if (pn < 4) { base = (u16*)(ws + R_QG); ld = 1024; c0 = pn * 256; }
            else if (pn < 8) { base = (u16*)(ws + R_KG); ld = 1024; c0 = (pn - 4) * 256; }
            else if (pn < 16) { base = (u16*)(ws + R_VG); ld = 2048; c0 = (pn - 8) * 256; }
            else if (pn < 24) { base = (u16*)(ws + R_RG); ld = 2048; c0 = (pn - 16) * 256; }
            else if (pn < 28) { base = (u16*)(ws + R_QA); ld = 1024; c0 = (pn - 24) * 256; }
            else if (pn < 44) { base = (u16*)(ws + R_MG); ld = 2048; c0 = (pn - 36) * 256; bias = merge_b; }
            else { base = (u16*)(ws + R_MA); ld = 2048; c0 = (pn - 44) * 256; bias = merge_b + 2048; }
            f32x4 bv[2][2];
#pragma unroll
            for (int bj = 0; bj < 2; ++bj)
#pragma unroll
                for (int n = 0; n < 2; ++n) bv[bj][n] = bias ? *(const f32x4*)(bias + c0 + bj * 128 + colt + 4 * n) : (f32x4){0.f, 0.f, 0.f, 0.f};
#pragma unroll
            for (int ai = 0; ai < 2; ++ai)
#pragma unroll
                for (int m = 0; m < 4; ++m) { u16* rowp = base + (size_t)(row0 + ai * 128 + m * 16) * ld + c0 + colt;
#pragma unroll
                    for (int bj = 0; bj < 2; ++bj) { f32x4 v0 = acc[ai][bj][m][0], v1 = acc[ai][bj][m][1];
                        if (bias) {
#pragma unroll
                            for (int j = 0; j < 4; ++j) { v0[j] = sigmoidf_(v0[j] + bv[bj][0][j]); v1[j] = sigmoidf_(v1[j] + bv[bj][1][j]); } }
                        *(u32x4*)(rowp + bj * 128) = pack8(v0, v1); } }
        } else if (pn < 36) {
            const bool isv = pn >= 32; const int c0 = (pn - (isv ? 32 : 28)) * 256;
            float* op = out + (isv ? O_VP : O_KP); float* os = out + (isv ? O_VS : O_KS);
            u16* kab = (u16*)(ws + R_KA); u16* vat = (u16*)(ws + R_VAT);
#pragma unroll
            for (int ai = 0; ai < 2; ++ai)
#pragma unroll
                for (int m = 0; m < 4; ++m) { const int row = row0 + ai * 128 + m * 16;
#pragma unroll
                    for (int bj = 0; bj < 2; ++bj) { const int c = c0 + bj * 128 + colt; const f32x4 v0 = acc[ai][bj][m][0], v1 = acc[ai][bj][m][1];
                        if (row < MP) { const int t = row & 2047, b = row >> 11;
                            if (t >= 1536) { float* d = op + ((size_t)(b * 512 + t - 1536)) * 1024 + c; *(f32x4*)d = v0; *(f32x4*)(d + 4) = v1; }
                            if (!isv) *(u32x4*)(kab + (size_t)row * 1024 + c) = pack8(v0, v1);
                            else { const int hh = c >> 7, d0 = c & 127; u16* vp = vat + ((size_t)((b * 8 + hh) * 128 + d0)) * 2048 + t;
#pragma unroll
                                for (int j = 0; j < 4; ++j) { vp[(size_t)j * 2048] = f2bf(v0[j]); vp[(size_t)(j + 4) * 2048] = f2bf(v1[j]); } }
                        } else { float* d = os + (size_t)(row - MP) * 1024 + c; *(f32x4*)d = v0; *(f32x4*)(d + 4) = v1; } } }
        } else {
            if (wc == 0 && fq < 2) { float* alo = (float*)(ws + R_ALO);
#pragma unroll
                for (int ai = 0; ai < 2; ++ai)
#pragma unroll
                    for (int m = 0; m < 4; ++m) { float* d = alo + (size_t)(row0 + ai * 128 + m * 16) * 16 + 8 * fq; *(f32x4*)d = acc[ai][0][m][0]; *(f32x4*)(d + 4) = acc[ai][0][m][1]; } }
        }
    }
};

struct EpiBr1 {
    static constexpr bool PERM = true, AFTER_DRAIN = false;
    const u16* gate; float* t1;
    __device__ __forceinline__ void operator()(const f32x4 (&acc)[2][2][4][2], const Unit& u, int wr, int wc, int fr, int fq) const {
        const int row0 = u.pm * 256 + wr * 64 + fr, col0 = u.pn * 256 + wc * 32 + 8 * fq;
#pragma unroll
        for (int ai = 0; ai < 2; ++ai)
#pragma unroll
            for (int m = 0; m < 4; ++m) { const size_t ro = (size_t)(row0 + ai * 128 + m * 16) * 2048 + col0;
#pragma unroll
                for (int bj = 0; bj < 2; ++bj) { const u32x4 g = *(const u32x4*)(gate + ro + bj * 128); const f32x4 v0 = acc[ai][bj][m][0], v1 = acc[ai][bj][m][1];
                    f32x4 o0 = {v0[0] * bf_lo(g.x), v0[1] * bf_hi(g.x), v0[2] * bf_lo(g.y), v0[3] * bf_hi(g.y)}, o1 = {v1[0] * bf_lo(g.z), v1[1] * bf_hi(g.z), v1[2] * bf_lo(g.w), v1[3] * bf_hi(g.w)};
                    float* d = t1 + ro + bj * 128; *(f32x4*)d = o0; *(f32x4*)(d + 4) = o1; } }
    }
};
struct EpiBr2 {
    static constexpr bool PERM = true, AFTER_DRAIN = false;
    const u16* gate; const float* t1; u16* t;
    __device__ __forceinline__ void operator()(const f32x4 (&acc)[2][2][4][2], const Unit& u, int wr, int wc, int fr, int fq) const {
        const int row0 = u.pm * 256 + wr * 64 + fr, col0 = u.pn * 256 + wc * 32 + 8 * fq;
#pragma unroll
        for (int ai = 0; ai < 2; ++ai)
#pragma unroll
            for (int m = 0; m < 4; ++m) { const size_t ro = (size_t)(row0 + ai * 128 + m * 16) * 2048 + col0;
#pragma unroll
                for (int bj = 0; bj < 2; ++bj) { const u32x4 g = *(const u32x4*)(gate + ro + bj * 128); const f32x4 v0 = acc[ai][bj][m][0], v1 = acc[ai][bj][m][1];
                    const float* s = t1 + ro + bj * 128; const f32x4 a0 = *(const f32x4*)s, a1 = *(const f32x4*)(s + 4);
                    f32x4 o0 = {a0[0] + v0[0] * bf_lo(g.x), a0[1] + v0[1] * bf_hi(g.x), a0[2] + v0[2] * bf_lo(g.y), a0[3] + v0[3] * bf_hi(g.y)};
                    f32x4 o1 = {a1[0] + v1[0] * bf_lo(g.z), a1[1] + v1[1] * bf_hi(g.z), a1[2] + v1[2] * bf_lo(g.w), a1[3] + v1[3] * bf_hi(g.w)};
                    *(u32x4*)(t + ro + bj * 128) = pack8(o0, o1); } }
    }
};
struct EpiOut {
    static constexpr bool PERM = false, AFTER_DRAIN = false;
    const float *xp, *xs; float* dst;
    __device__ __forceinline__ void operator()(const f32x4 (&acc)[2][2][4][2], const Unit& u, int wr, int wc, int fr, int fq) const {
        const int row0 = u.pm * 256 + wr * 64 + fr, col0 = u.pn * 256 + wc * 32 + 4 * fq;
#pragma unroll
        for (int ai = 0; ai < 2; ++ai)
#pragma unroll
            for (int m = 0; m < 4; ++m) { const int row = row0 + ai * 128 + m * 16; const float* xr = row < MP ? xp + (size_t)row * 2048 : xs + (size_t)(row - MP) * 2048;
#pragma unroll
                for (int bj = 0; bj < 2; ++bj)
#pragma unroll
                    for (int n = 0; n < 2; ++n) { const int c = col0 + bj * 128 + n * 16; const f32x4 xv = *(const f32x4*)(xr + c); *(f32x4*)(dst + (size_t)row * 2048 + c) = xv * DN_ALPHA + acc[ai][bj][m][n]; } }
    }
};
struct EpiDown {
    static constexpr bool PERM = false, AFTER_DRAIN = false;
    const u16* hb; float* dst;
    __device__ __forceinline__ void operator()(const f32x4 (&acc)[2][2][4][2], const Unit& u, int wr, int wc, int fr, int fq) const {
        const int row0 = u.pm * 256 + wr * 64 + fr, col0 = u.pn * 256 + wc * 32 + 4 * fq;
#pragma unroll
        for (int ai = 0; ai < 2; ++ai)
#pragma unroll
            for (int m = 0; m < 4; ++m) { const size_t ro = (size_t)(row0 + ai * 128 + m * 16) * 2048;
#pragma unroll
                for (int bj = 0; bj < 2; ++bj)
#pragma unroll
                    for (int n = 0; n < 2; ++n) { const int c = col0 + bj * 128 + n * 16; const u32x2 hv = *(const u32x2*)(hb + ro + c);
                        f32x4 hf = {bf_lo(hv.x), bf_hi(hv.x), bf_lo(hv.y), bf_hi(hv.y)}; *(f32x4*)(dst + ro + c) = hf * DN_ALPHA + acc[ai][bj][m][n]; } }
    }
};
struct EpiUp {
    static constexpr bool PERM = true, AFTER_DRAIN = false;
    const float *conv_w, *conv_b, *state_conv; float* out; u16* a; float *uh, *uf, *gf;
    __device__ __forceinline__ void operator()(const f32x4 (&acc)[2][2][4][2], const Unit& u, int wr, int wc, int fr, int fq) const {
        const int lane = fq * 16 + fr, ch = u.pn * 128 + wc * 32 + 8 * fq;
        const int src1 = (lane & 48) | ((fr + 15) & 15), src2 = (lane & 48) | ((fr + 14) & 15);
        f32x4 w0[2], w1[2], w2[2], cb[2];
#pragma unroll
        for (int n = 0; n < 2; ++n) { w0[n] = *(const f32x4*)(conv_w + ch + 4 * n); w1[n] = *(const f32x4*)(conv_w + DFF + ch + 4 * n); w2[n] = *(const f32x4*)(conv_w + 2 * DFF + ch + 4 * n); cb[n] = *(const f32x4*)(conv_b + ch + 4 * n); }
        const bool prompt = u.pm < 128;
#pragma unroll
        for (int ai = 0; ai < 2; ++ai) {
            const int seg = u.pm * 4 + ai * 2 + wr;
#pragma unroll
            for (int m = 0; m < 4; ++m) {
                const int row = seg * 64 + m * 16 + fr;
                f32x4 p1[2], p2[2];
#pragma unroll
                for (int n = 0; n < 2; ++n)
#pragma unroll
                    for (int j = 0; j < 4; ++j) {
                        const float cur = acc[ai][0][m][n][j], prv = m > 0 ? acc[ai][0][m > 0 ? m - 1 : 0][n][j] : 0.f;
                        p1[n][j] = __shfl(fr == 15 ? prv : cur, src1);
                        p2[n][j] = __shfl(fr >= 14 ? prv : cur, src2); }
                bool fix = false;
                if (prompt) {
                    const int t = row & 2047, b = row >> 11;
                    if (m == 0 && fr < 2) { fix = true; float* d = uf + ((size_t)seg * 2 + fr) * DFF + ch; float* e = gf + ((size_t)seg * 2 + fr) * DFF + ch;
                        *(f32x4*)d = acc[ai][0][m][0]; *(f32x4*)(d + 4) = acc[ai][0][m][1]; *(f32x4*)e = acc[ai][1][m][0]; *(f32x4*)(e + 4) = acc[ai][1][m][1]; }
                    if (m == 3 && fr >= 14) { float* d = uh + ((size_t)seg * 2 + (fr - 14)) * DFF + ch; *(f32x4*)d = acc[ai][0][m][0]; *(f32x4*)(d + 4) = acc[ai][0][m][1]; }
                    if (t >= 2046) { float* d = out + O_CP + ((size_t)b * 2 + (t - 2046)) * DFF + ch; *(f32x4*)d = acc[ai][0][m][0]; *(f32x4*)(d + 4) = acc[ai][0][m][1]; }
                } else {
                    const int rs = row - MP, ts = rs & 31, bs = rs >> 5;
                    if (ts < 2) { const float* s1 = state_conv + ((size_t)bs * 2 + 1) * DFF + ch; const float* s0 = state_conv + ((size_t)bs * 2) * DFF + ch;
                        const f32x4 a1 = *(const f32x4*)s1, b1 = *(const f32x4*)(s1 + 4), a0 = *(const f32x4*)s0, b0 = *(const f32x4*)(s0 + 4);
                        if (ts == 0) { p1[0] = a1; p1[1] = b1; p2[0] = a0; p2[1] = b0; } else { p2[0] = a1; p2[1] = b1; } }
                    if (ts >= 30) { float* d = out + O_CS + ((size_t)bs * 2 + (ts - 30)) * DFF + ch; *(f32x4*)d = acc[ai][0][m][0]; *(f32x4*)(d + 4) = acc[ai][0][m][1]; }
                }
                if (!fix) {
                    f32x4 r[2];
#pragma unroll
                    for (int n = 0; n < 2; ++n)
#pragma unroll
                        for (int j = 0; j < 4; ++j) { const float uc = cb[n][j] + w0[n][j] * p2[n][j] + w1[n][j] * p1[n][j] + w2[n][j] * acc[ai][0][m][n][j]; r[n][j] = gelu_tanh(uc) * acc[ai][1][m][n][j]; }
                    *(u32x4*)(a + (size_t)row * DFF + ch) = pack8(r[0], r[1]);
                }
            }
        }
    }
};

__device__ __forceinline__ void phase_fixup(const Params& p) {
    const float* uh = (const float*)(p.ws + R_SIDE); const float* uf = uh + SZ_SIDE / 4; const float* gf = uf + SZ_SIDE / 4; u16* a = (u16*)(p.ws + R_AACT);
    const int total = 512 * 2 * DFF;
    for (int i = blockIdx.x * 512 + threadIdx.x; i < total; i += gridDim.x * 512) {
        const int ch = i % DFF, sj = i / DFF, j = sj & 1, seg = sj >> 1, row = seg * 64 + j, t = row & 2047;
        const float u0 = uf[((size_t)seg * 2 + j) * DFF + ch], g0 = gf[((size_t)seg * 2 + j) * DFF + ch];
        float p1, p2;
        if (j == 0) { p1 = t == 0 ? 0.f : uh[((size_t)(seg - 1) * 2 + 1) * DFF + ch]; p2 = t == 0 ? 0.f : uh[((size_t)(seg - 1) * 2) * DFF + ch]; }
        else { p1 = uf[((size_t)seg * 2) * DFF + ch]; p2 = t == 1 ? 0.f : uh[((size_t)(seg - 1) * 2 + 1) * DFF + ch]; }
        const float uc = p.conv_b[ch] + p.conv_w[ch] * p2 + p.conv_w[DFF + ch] * p1 + p.conv_w[2 * DFF + ch] * u0;
        a[(size_t)row * DFF + ch] = f2bf(gelu_tanh(uc) * g0);
    }
}

__device__ __forceinline__ float logsig(float x) { return fminf(x, 0.f) - __logf(1.f + __expf(-fabsf(x))); }

__device__ __forceinline__ void gla_unit(LAS unsigned char* lds, const Params& p, int u) {
    const int tid = opaque_tid(), lane = tid & 63, w = __builtin_amdgcn_readfirstlane(tid >> 6), r = lane & 15, q = lane >> 4;
    const bool smp = u >= 256; const int uu = smp ? u - 256 : u;
    const int b = uu >> 4, h = (uu >> 2) & 3, vs = uu & 3;
    const int row_base = smp ? MP + b * 32 : b * 2048, nblk = smp ? 1 : 32, valid = smp ? 32 : 64;
    LAS u16* QT = (LAS u16*)(lds); LAS u16* KT = (LAS u16*)(lds + 33792); LAS u16* KTT = (LAS u16*)(lds + 67584); LAS u16* VT = (LAS u16*)(lds + 104448); LAS u16* PP = (LAS u16*)(lds + 122880);
    LAS float* ALO = (LAS float*)(lds + 132096); LAS float* CS = (LAS float*)(lds + 136192); LAS float* DEC = (LAS float*)(lds + 140288);
    const u16* qg = (const u16*)(p.ws + R_QG); const u16* kg = (const u16*)(p.ws + R_KG); const u16* vg = (const u16*)(p.ws + R_VG); const float* alo = (const float*)(p.ws + R_ALO);
    u16* og = (u16*)((unsigned char*)p.out + SZ_R2);
    const int kc = tid & 127, rg = tid >> 7;
    float gu0[16], gu1[16];
#pragma unroll
    for (int i = 0; i < 16; ++i) { gu0[i] = p.gate_up[i * 1024 + h * 256 + 2 * kc]; gu1[i] = p.gate_up[i * 1024 + h * 256 + 2 * kc + 1]; }
    const float gb0 = p.gate_b[h * 256 + 2 * kc], gb1 = p.gate_b[h * 256 + 2 * kc + 1];
    f32x4 S[16];
    const size_t sbase_u = ((size_t)(b * 4 + h) * 256) * 512 + vs * 128 + 16 * w;
    const int soff = 4 * q * 512 + r;
#pragma unroll
    for (int i = 0; i < 16; ++i) {
#pragma unroll
        for (int j = 0; j < 4; ++j) S[i][j] = smp ? (p.state_gla + sbase_u)[soff + (16 * i + j) * 512] : 0.f;
        __builtin_amdgcn_sched_barrier(0); }
    for (int n = 0; n < nblk; ++n) {
        const int r0 = row_base + 64 * n;
        if (tid < 256) { const int t = tid >> 2, c4 = tid & 3; const int row = min(r0 + t, M - 1); *(LAS f32x4*)(ALO + t * 16 + 4 * c4) = *(const f32x4*)(alo + (size_t)row * 16 + 4 * c4); }
#pragma unroll
        for (int i = 0; i < 2; ++i) { const int id = tid + 512 * i, s = id >> 4, c8 = id & 15; u32x4 v = {0u, 0u, 0u, 0u};
            if (s < valid) v = *(const u32x4*)(vg + (size_t)(r0 + s) * 2048 + h * 512 + vs * 128 + 8 * c8);
#pragma unroll
            for (int jj = 0; jj < 4; ++jj) { VT[(8 * c8 + 2 * jj) * 72 + s] = (u16)(v[jj] & 0xffffu); VT[(8 * c8 + 2 * jj + 1) * 72 + s] = (u16)(v[jj] >> 16); } }
        __syncthreads();
        float run0 = 0.f, run1 = 0.f;
#pragma unroll 1
        for (int rr = 0; rr < 16; ++rr) { const int t = 16 * rg + rr; float x0 = gb0, x1 = gb1;
#pragma unroll
            for (int i4 = 0; i4 < 4; ++i4) { const f32x4 a = *(const LAS f32x4*)(ALO + t * 16 + 4 * i4);
#pragma unroll
                for (int e = 0; e < 4; ++e) { x0 += a[e] * gu0[4 * i4 + e]; x1 += a[e] * gu1[4 * i4 + e]; } }
            if (t < valid) { run0 += logsig(x0) * 0.0625f; run1 += logsig(x1) * 0.0625f; } }
        CS[rg * 256 + 2 * kc] = run0; CS[rg * 256 + 2 * kc + 1] = run1;
        __syncthreads();
        float pre0 = 0.f, pre1 = 0.f, tot0 = 0.f, tot1 = 0.f;
#pragma unroll
        for (int g = 0; g < 4; ++g) { const float c0 = CS[g * 256 + 2 * kc], c1 = CS[g * 256 + 2 * kc + 1]; tot0 += c0; tot1 += c1; if (g < rg) { pre0 += c0; pre1 += c1; } }
        if (rg == 0) { DEC[2 * kc] = __expf(tot0); DEC[2 * kc + 1] = __expf(tot1); }
#pragma unroll 1
        for (int rp = 0; rp < 8; ++rp) { float ka[2], kb[2];
#pragma unroll
            for (int e = 0; e < 2; ++e) { const int t = 16 * rg + 2 * rp + e; float x0 = gb0, x1 = gb1;
#pragma unroll
                for (int i4 = 0; i4 < 4; ++i4) { const f32x4 a = *(const LAS f32x4*)(ALO + t * 16 + 4 * i4);
#pragma unroll
                    for (int e2 = 0; e2 < 4; ++e2) { x0 += a[e2] * gu0[4 * i4 + e2]; x1 += a[e2] * gu1[4 * i4 + e2]; } }
                unsigned qr = 0u, kr = 0u;
                if (t < valid) { pre0 += logsig(x0) * 0.0625f; pre1 += logsig(x1) * 0.0625f; const size_t o = (size_t)(r0 + t) * 1024 + h * 256 + 2 * kc; qr = *(const unsigned*)(qg + o); kr = *(const unsigned*)(kg + o); }
                const float q0 = bf_lo(qr) * 0.0625f * __expf(pre0), q1 = bf_hi(qr) * 0.0625f * __expf(pre1);
                ka[e] = bf_lo(kr) * __expf(-pre0); kb[e] = bf_hi(kr) * __expf(-pre1);
                *(LAS unsigned*)(QT + t * 264 + 2 * kc) = cvt_pk_bf16(q0, q1); *(LAS unsigned*)(KT + t * 264 + 2 * kc) = cvt_pk_bf16(ka[e], kb[e]); }
            LAS u16* d0 = KTT + (2 * kc) * 72 + 16 * rg + 2 * rp;
            *(LAS unsigned*)d0 = cvt_pk_bf16(ka[0], ka[1]); *(LAS unsigned*)(d0 + 72) = cvt_pk_bf16(kb[0], kb[1]); }
        __syncthreads();
        { const int mt = w >> 1;
#pragma unroll
          for (int tt = 0; tt < 2; ++tt) { const int nt = 2 * (w & 1) + tt; f32x4 c = {0.f, 0.f, 0.f, 0.f};
              if (nt <= mt) {
#pragma unroll
                  for (int ks = 0; ks < 8; ++ks) { const bf16x8 a = *(const LAS bf16x8*)(QT + (16 * mt + r) * 264 + 32 * ks + 8 * q); const bf16x8 bb = *(const LAS bf16x8*)(KT + (16 * nt + r) * 264 + 32 * ks + 8 * q); c = mfma16(a, bb, c); } }
#pragma unroll
              for (int j = 0; j < 4; ++j) { const int t = 16 * mt + 4 * q + j, s = 16 * nt + r; PP[t * 72 + s] = f2bf(s <= t ? c[j] : 0.f); } } }
        f32x4 oacc[4];
#pragma unroll
        for (int mt = 0; mt < 4; ++mt) oacc[mt] = (f32x4){0.f, 0.f, 0.f, 0.f};
#pragma unroll
        for (int pp = 0; pp < 8; ++pp) { u32x4 bw; bw.x = cvt_pk_bf16(S[2 * pp][0], S[2 * pp][1]); bw.y = cvt_pk_bf16(S[2 * pp][2], S[2 * pp][3]); bw.z = cvt_pk_bf16(S[2 * pp + 1][0], S[2 * pp + 1][1]); bw.w = cvt_pk_bf16(S[2 * pp + 1][2], S[2 * pp + 1][3]);
#pragma unroll
            for (int mt = 0; mt < 4; ++mt) { const u32x2 a0 = *(const LAS u32x2*)(QT + (16 * mt + r) * 264 + 32 * pp + 4 * q), a1 = *(const LAS u32x2*)(QT + (16 * mt + r) * 264 + 32 * pp + 16 + 4 * q);
                const u32x4 aw = {a0.x, a0.y, a1.x, a1.y}; oacc[mt] = mfma16(as_bf8(aw), as_bf8(bw), oacc[mt]); }
            __builtin_amdgcn_sched_barrier(0); }
        __syncthreads();
        bf16x8 bv[2];
#pragma unroll
        for (int ks = 0; ks < 2; ++ks) bv[ks] = *(const LAS bf16x8*)(VT + (16 * w + r) * 72 + 32 * ks + 8 * q);
#pragma unroll
        for (int mt = 0; mt < 4; ++mt) {
#pragma unroll
            for (int ks = 0; ks < 2; ++ks) { const bf16x8 a = *(const LAS bf16x8*)(PP + (16 * mt + r) * 72 + 32 * ks + 8 * q); oacc[mt] = mfma16(a, bv[ks], oacc[mt]); }
#pragma unroll
            for (int j = 0; j < 4; ++j) { const int t = 16 * mt + 4 * q + j; if (t < valid) og[(size_t)(r0 + t) * 2048 + h * 512 + vs * 128 + 16 * w + r] = f2bf(oacc[mt][j]); } }
#pragma unroll
        for (int i = 0; i < 16; ++i) {
#pragma unroll
            for (int ks = 0; ks < 2; ++ks) { const bf16x8 a = *(const LAS bf16x8*)(KTT + (16 * i + r) * 72 + 32 * ks + 8 * q); S[i] = mfma16(a, bv[ks], S[i]); }
            const f32x4 d = *(const LAS f32x4*)(DEC + 16 * i + 4 * q); S[i] = S[i] * d; __builtin_amdgcn_sched_barrier(0); }
        __syncthreads();
    }
    float* so = p.out + (smp ? O_SS : O_SP);
#pragma unroll
    for (int i = 0; i < 16; ++i) {
#pragma unroll
        for (int j = 0; j < 4; ++j) (so + sbase_u)[soff + (16 * i + j) * 512] = S[i][j];
        __builtin_amdgcn_sched_barrier(0); }
}

__device__ __forceinline__ void attn_unit(LAS unsigned char* lds, const Params& p, int u) {
    const int tid = opaque_tid(), lane = tid & 63, w = __builtin_amdgcn_readfirstlane(tid >> 6), r = lane & 15, q = lane >> 4, rt = w & 3, kh = w >> 2;
    LAS u16* PL = (LAS u16*)lds; LAS float* RED = (LAS float*)(lds + 75776); LAS float* LSUM = RED + 128;
    const bool smp = u >= 4096;
    int b, h, c = 0, nkc = 9, NT, rq0;
    if (!smp) { c = u & 31; h = (u >> 5) & 7; b = u >> 8; nkc = min(c, 8) + 1; NT = 4 * nkc; rq0 = b * 2048 + c * 64; }
    else { const int us = u - 4096; h = us & 7; b = us >> 3; NT = 34; rq0 = MP + b * 32; }
    const int tk0 = smp ? 0 : (c - (nkc - 1)) * 64;
    u16* qa = (u16*)(p.ws + R_QA); const u16* kab = (const u16*)(p.ws + R_KA); const u16* vat = (const u16*)(p.ws + R_VAT);
    const float* ksn = p.out + O_KS; const float* vsn = p.out + O_VS;
    const int qrow = min(rq0 + 16 * rt + r, M - 1);
    bf16x8 qf[4];
#pragma unroll
    for (int ks = 0; ks < 4; ++ks) qf[ks] = *(const bf16x8*)(qa + (size_t)qrow * 1024 + h * 128 + 32 * ks + 8 * q);
    const float* bias = p.rel_bias + h * 257;
    f32x4 sc[18];
#pragma unroll
    for (int i = 0; i < 18; ++i) { const int kt = kh * 18 + i;
        if (kt < NT) { f32x4 ca = {0.f, 0.f, 0.f, 0.f};
            if (!smp) { const u16* kp = kab + (size_t)(b * 2048 + tk0 + 16 * kt + r) * 1024 + h * 128 + 8 * q;
#pragma unroll
                for (int ks = 0; ks < 4; ++ks) { const bf16x8 kf = *(const bf16x8*)(kp + 32 * ks); ca = mfma16(qf[ks], kf, ca); } }
            else { const int key = 16 * kt + r; const float* kp = (key < 512 ? p.cache_k + ((size_t)(b * 512 + key) * 8 + h) * 128 : ksn + ((size_t)(b * 32 + key - 512) * 8 + h) * 128) + 8 * q;
#pragma unroll
                for (int ks = 0; ks < 4; ++ks) { const f32x4 x0 = *(const f32x4*)(kp + 32 * ks), x1 = *(const f32x4*)(kp + 32 * ks + 4); ca = mfma16(qf[ks], as_bf8(pack8(x0, x1)), ca); } }
#pragma unroll
            for (int j = 0; j < 4; ++j) { const int qi = 16 * rt + 4 * q + j, key = 16 * kt + r; int rel = smp ? 512 + qi - key : qi - (key - 64 * (nkc - 1)); rel = max(-128, min(128, rel));
                sc[i][j] = ca[j] * 0.08838834764831845f + bias[rel + 128]; }
        } else sc[i] = (f32x4){-1e30f, -1e30f, -1e30f, -1e30f}; }
    float mx[4];
#pragma unroll
    for (int j = 0; j < 4; ++j) { float m = -1e30f;
#pragma unroll
        for (int i = 0; i < 18; ++i) m = fmaxf(m, sc[i][j]);
#pragma unroll
        for (int o = 1; o < 16; o <<= 1) m = fmaxf(m, __shfl_xor(m, o));
        mx[j] = m; if (r == 0) RED[kh * 64 + 16 * rt + 4 * q + j] = m; }
    __syncthreads();
    float ls[4];
#pragma unroll
    for (int j = 0; j < 4; ++j) { mx[j] = fmaxf(mx[j], RED[(1 - kh) * 64 + 16 * rt + 4 * q + j]); ls[j] = 0.f; }
#pragma unroll
    for (int i = 0; i < 18; ++i) { const int kt = kh * 18 + i;
        if (kt < NT) {
#pragma unroll
            for (int j = 0; j < 4; ++j) { const float pv = __expf(sc[i][j] - mx[j]); ls[j] += pv; PL[(16 * rt + 4 * q + j) * 592 + 16 * kt + r] = f2bf(pv); } } }
#pragma unroll
    for (int j = 0; j < 4; ++j) { float s = ls[j];
#pragma unroll
        for (int o = 1; o < 16; o <<= 1) s += __shfl_xor(s, o);
        if (r == 0) LSUM[kh * 64 + 16 * rt + 4 * q + j] = s; }
    __syncthreads();
    const int dh = kh;
    f32x4 o[4];
#pragma unroll
    for (int dt = 0; dt < 4; ++dt) o[dt] = (f32x4){0.f, 0.f, 0.f, 0.f};
    for (int ks = 0; ks < NT / 2; ++ks) {
        const bf16x8 a = *(const LAS bf16x8*)(PL + (16 * rt + r) * 592 + 32 * ks + 8 * q);
#pragma unroll
        for (int dt = 0; dt < 4; ++dt) { const int d = 64 * dh + 16 * dt + r; bf16x8 bvv;
            if (!smp) bvv = *(const bf16x8*)(vat + ((size_t)((b * 8 + h) * 128 + d)) * 2048 + tk0 + 32 * ks + 8 * q);
            else { const int key0 = 32 * ks + 8 * q; const float* vp = key0 < 512 ? p.cache_v + ((size_t)(b * 512 + key0) * 8 + h) * 128 + d : vsn + ((size_t)(b * 32 + key0 - 512) * 8 + h) * 128 + d;
                f32x4 x0, x1;
#pragma unroll
                for (int e = 0; e < 4; ++e) { x0[e] = vp[(size_t)e * 1024]; x1[e] = vp[(size_t)(e + 4) * 1024]; }
                bvv = as_bf8(pack8(x0, x1)); }
            o[dt] = mfma16(a, bvv, o[dt]); } }
#pragma unroll
    for (int j = 0; j < 4; ++j) { const int row = 16 * rt + 4 * q + j; const float inv = 1.f / (LSUM[row] + LSUM[64 + row]);
        if (!smp || row < 32) {
#pragma unroll
            for (int dt = 0; dt < 4; ++dt) qa[(size_t)(rq0 + row) * 1024 + h * 128 + 64 * dh + 16 * dt + r] = f2bf(o[dt][j] * inv); } }
    __syncthreads();
}

__device__ __forceinline__ void phase_normgate(const Params& p) {
    const int lane = threadIdx.x & 63, gw = blockIdx.x * 8 + (threadIdx.x >> 6), NGW = gridDim.x * 8;
    u16* og = (u16*)((unsigned char*)p.out + SZ_R2); const u16* rgb = (const u16*)(p.ws + R_RG);
    for (int it = gw; it < M * 4; it += NGW) { const int row = it >> 2, h = it & 3; const size_t o = (size_t)row * 2048 + h * 512 + 8 * lane;
        const u32x4 ov = *(const u32x4*)(og + o), rv = *(const u32x4*)(rgb + o);
        float v[8] = {bf_lo(ov.x), bf_hi(ov.x), bf_lo(ov.y), bf_hi(ov.y), bf_lo(ov.z), bf_hi(ov.z), bf_lo(ov.w), bf_hi(ov.w)};
        float rr[8] = {bf_lo(rv.x), bf_hi(rv.x), bf_lo(rv.y), bf_hi(rv.y), bf_lo(rv.z), bf_hi(rv.z), bf_lo(rv.w), bf_hi(rv.w)};
        float ss = 0.f;
#pragma unroll
        for (int e = 0; e < 8; ++e) ss += v[e] * v[e];
        const float rstd = rsqrtf(wave_sum(ss) * (1.f / 512.f) + 1e-6f);
        const f32x4 g0 = *(const f32x4*)(p.norm_g + h * 512 + 8 * lane), g1 = *(const f32x4*)(p.norm_g + h * 512 + 8 * lane + 4);
        float res[8];
#pragma unroll
        for (int e = 0; e < 8; ++e) { const float g = e < 4 ? g0[e] : g1[e - 4]; res[e] = v[e] * rstd * g * (rr[e] / (1.f + __expf(-rr[e]))); }
        u32x4 w; w.x = cvt_pk_bf16(res[0], res[1]); w.y = cvt_pk_bf16(res[2], res[3]); w.z = cvt_pk_bf16(res[4], res[5]); w.w = cvt_pk_bf16(res[6], res[7]);
        *(u32x4*)(og + o) = w; }
}
template <bool TO_BF16>
__device__ __forceinline__ void phase_ln(const float* src, const float* g, const float* bta, u16* dstb, float* dstf) {
    const int lane = threadIdx.x & 63, gw = blockIdx.x * 8 + (threadIdx.x >> 6), NGW = gridDim.x * 8;
    for (int row = gw; row < M; row += NGW) { const float* s = src + (size_t)row * 2048;
        f32x4 v[8]; float sum = 0.f;
#pragma unroll
        for (int j = 0; j < 8; ++j) { v[j] = *(const f32x4*)(s + (j * 64 + lane) * 4); sum += (v[j][0] + v[j][1]) + (v[j][2] + v[j][3]); }
        const float mean = wave_sum(sum) * (1.f / 2048.f); float s2 = 0.f;
#pragma unroll
        for (int j = 0; j < 8; ++j) { v[j] = v[j] - mean; s2 += (v[j][0] * v[j][0] + v[j][1] * v[j][1]) + (v[j][2] * v[j][2] + v[j][3] * v[j][3]); }
        const float rstd = rsqrtf(wave_sum(s2) * (1.f / 2048.f) + 1e-5f);
#pragma unroll
        for (int j = 0; j < 8; ++j) { const int c = (j * 64 + lane) * 4; const f32x4 gg = *(const f32x4*)(g + c), bb = *(const f32x4*)(bta + c); const f32x4 y = v[j] * rstd * gg + bb;
            if (TO_BF16) { u32x2 w; w.x = cvt_pk_bf16(y[0], y[1]); w.y = cvt_pk_bf16(y[2], y[3]); *(u32x2*)(dstb + (size_t)row * 2048 + c) = w; }
            else *(f32x4*)(dstf + (size_t)row * 2048 + c) = y; } }
}

template <class Epi>
__device__ __forceinline__ void run_gemm(LAS unsigned char* lds, const u16* A, const u16* Bt, int N, int K, const Epi& E) {
    pg8::Gemm g; g.A = A; g.Bt = Bt; g.M = M; g.N = N; g.K = K;
    pg8::StaticOrder S; S.init(M, N, (int)gridDim.x, (int)blockIdx.x);
    pg8::gemm_phase<Epi, pg8::StaticOrder, false>(lds, g, S, E, nullptr);
}

__device__ __forceinline__ void gsync(cg::grid_group& g) { asm volatile("s_waitcnt vmcnt(0) lgkmcnt(0)" ::: "memory"); __builtin_amdgcn_fence(__ATOMIC_RELEASE, "agent"); g.sync(); __builtin_amdgcn_fence(__ATOMIC_ACQUIRE, "agent"); }

__global__ __launch_bounds__(512, 2) void fwd_megakernel(Params p) {
    extern __shared__ __attribute__((aligned(16))) unsigned char shm[];
    LAS unsigned char* lds = (LAS unsigned char*)shm;
    cg::grid_group grid = cg::this_grid();
    unsigned char* ws = p.ws;
    phase0(lds, p);
    gsync(grid);
#if defined(STOP_AFTER) && STOP_AFTER == 1
    return;
#endif
#ifndef SKIP_Z
    { EpiZ E; E.ws = ws; E.out = p.out; E.merge_b = p.merge_b; run_gemm(lds, (const u16*)p.out, (const u16*)(ws + W_IN), ZN, 2048, E); }
#endif
    gsync(grid);
#if defined(STOP_AFTER) && STOP_AFTER == 2
    return;
#endif
#ifndef SKIP_GLA
    for (int u = blockIdx.x; u < 768; u += gridDim.x) gla_unit(lds, p, u);
#endif
#ifdef DBG_COPY
    { const u32x4* src = (const u32x4*)(ws + R_VG); u32x4* dst = (u32x4*)((unsigned char*)p.out + SZ_R2); const size_t n16 = SZ_R2 / 16;
      for (size_t i = (size_t)blockIdx.x * 512 + threadIdx.x; i < n16; i += (size_t)gridDim.x * 512) dst[i] = src[i]; }
#endif
#ifndef SKIP_ATT
    for (int u = blockIdx.x; u < 4352; u += gridDim.x) attn_unit(lds, p, u);
#endif
    gsync(grid);
#if defined(STOP_AFTER) && STOP_AFTER == 3
    return;
#endif
    phase_normgate(p);
    gsync(grid);
#if defined(STOP_AFTER) && STOP_AFTER == 4
    return;
#endif
    { EpiBr1 E; E.gate = (const u16*)(ws + R_MG); E.t1 = (float*)(ws + R_T1); run_gemm(lds, (const u16*)((unsigned char*)p.out + SZ_R2), (const u16*)(ws + W_BRG), 2048, 2048, E); }
    gsync(grid);
#if defined(STOP_AFTER) && STOP_AFTER == 5
    return;
#endif
    { EpiBr2 E; E.gate = (const u16*)(ws + R_MA); E.t1 = (const float*)(ws + R_T1); E.t = (u16*)(ws + R_T); run_gemm(lds, (const u16*)(ws + R_QA), (const u16*)(ws + W_BRA), 2048, 1024, E); }
    gsync(grid);
#if defined(STOP_AFTER) && STOP_AFTER == 6
    return;
#endif
    { EpiOut E; E.xp = p.x_prompt; E.xs = p.x_sample; E.dst = p.out; run_gemm(lds, (const u16*)(ws + R_T), (const u16*)(ws + W_OUT), 2048, 2048, E); }
    gsync(grid);
#if defined(STOP_AFTER) && STOP_AFTER == 7
    return;
#endif
    phase_ln<true>(p.out, p.ln1_g, p.ln1_b, (u16*)(ws + R_HB), nullptr);
    gsync(grid);
#if defined(STOP_AFTER) && STOP_AFTER == 8
    return;
#endif
#ifndef SKIP_UP
    { EpiUp E; E.conv_w = p.conv_w; E.conv_b = p.conv_b; E.state_conv = p.state_conv; E.out = p.out; E.a = (u16*)(ws + R_AACT);
      E.uh = (float*)(ws + R_SIDE); E.uf = E.uh + SZ_SIDE / 4; E.gf = E.uf + SZ_SIDE / 4; run_gemm(lds, (const u16*)(ws + R_HB), (const u16*)(ws + W_UP), NUP, 2048, E); }
#endif
    gsync(grid);
#if defined(STOP_AFTER) && STOP_AFTER == 9
    return;
#endif
    phase_fixup(p);
    gsync(grid);
#if defined(STOP_AFTER) && STOP_AFTER == 10
    return;
#endif
    { EpiDown E; E.hb = (const u16*)(ws + R_HB); E.dst = p.out; run_gemm(lds, (const u16*)(ws + R_AACT), (const u16*)(ws + W_DN), 2048, DFF, E); }
    gsync(grid);
#if defined(STOP_AFTER) && STOP_AFTER == 11
    return;
#endif
    phase_ln<false>(p.out, p.ln2_g, p.ln2_b, nullptr, p.out);
}

extern "C" void kernel_launch(void* const* d_in, const int* in_sizes, int n_in, void* d_out, int out_size, void* d_ws, size_t ws_size, hipStream_t stream) {
    static int grid_blocks = 0;
    if (!grid_blocks) {
        if (n_in != 23 || ws_size < WS_END) { fprintf(stderr, "kernel_launch: need 23 inputs and >= %zu bytes of workspace (got %d, %zu)\n", (size_t)WS_END, n_in, ws_size); grid_blocks = -1; return; }
        int dev = 0, cus = 0, per_cu = 0;
        hipGetDevice(&dev);
        hipDeviceGetAttribute(&cus, hipDeviceAttributeMultiprocessorCount, dev);
        if (hipFuncSetAttribute((const void*)fwd_megakernel, hipFuncAttributeMaxDynamicSharedMemorySize, LDS_BYTES) != hipSuccess) { fprintf(stderr, "kernel_launch: hipFuncSetAttribute failed\n"); grid_blocks = -1; return; }
        hipOccupancyMaxActiveBlocksPerMultiprocessor(&per_cu, (const void*)fwd_megakernel, 512, LDS_BYTES);
        if (per_cu < 1) { fprintf(stderr, "kernel_launch: occupancy query says %d blocks per CU\n", per_cu); per_cu = 1; }
        (void)hipGetLastError();
        grid_blocks = cus * per_cu;
    }
    if (grid_blocks < 0) return;
    Params p{};
    const float** f = (const float**)&p;
    for (int i = 0; i < 23; ++i) f[i] = (const float*)d_in[i];
    p.out = (float*)d_out; p.ws = (unsigned char*)d_ws;
    void* args[] = {&p};
    hipError_t e = hipLaunchCooperativeKernel((const void*)fwd_megakernel, dim3(grid_blocks), dim3(512), args, LDS_BYTES, stream);
    if (e != hipSuccess) fprintf(stderr, "cooperative launch failed: %s (grid %d)\n", hipGetErrorString(e), grid_blocks);
}
```

```cpp
#include <hip/hip_runtime.h>
#include <hip/hip_cooperative_groups.h>
#include <cstdio>
namespace cg = cooperative_groups;
namespace pg8 {
#define PG8_LAS __attribute__((address_space(3)))
typedef unsigned short bf16_t;
typedef short bf16x8 __attribute__((ext_vector_type(8)));
typedef float f32x4 __attribute__((ext_vector_type(4)));
typedef unsigned u32x4 __attribute__((ext_vector_type(4)));
constexpr int BM = 256, BK = 64, HALF = 128, HTB = HALF * BK * 2  , STAGE_BYTES = 8 * HTB, NXCD = 8, WGM = 4;

__host__ __device__ __forceinline__ int lds_byte(int r, int c) { const int st = (r >> 4) * 2 + (c >> 5), rr = r & 15, cc = c & 31, ob = rr * 64 + cc * 2; return st * 1024 + (ob ^ (((ob >> 9) & 1) << 5)); }
__host__ __device__ __forceinline__ void stage_rc(int b, int& R, int& C) { const int st = b / 1024, sb = b % 1024, swz = sb ^ (((sb >> 9) & 1) << 5); R = (st >> 1) * 16 + swz / 64; C = (st & 1) * 32 + (swz % 64) / 2; }
__host__ __device__ __forceinline__ int perm32(int rho) { const int n = rho >> 4, i = rho & 15; return 8 * (i >> 2) + 4 * n + (i & 3); }

struct Unit { int pm, pn; };
struct Gemm { const bf16_t* A; const bf16_t* Bt; int M, N, K; };

struct StaticOrder {
    int nM, nN, nwg, G, c;
    __host__ __device__ void init(int M, int N, int G_, int c_) { nM = M / BM; nN = N / BM; nwg = nM * nN; G = G_; c = c_; }
    __host__ __device__ bool next(int i, Unit& u) const {
        const long L = (long)i * G + c; if (L >= nwg) return false;
        int wgid = (int)L; { const int q = nwg / NXCD, r = nwg % NXCD, xcd = wgid % NXCD, off = wgid / NXCD; wgid = (xcd < r ? xcd * (q + 1) : r * (q + 1) + (xcd - r) * q) + off; }
        const int nig = WGM * nN, gid = wgid / nig, fm = gid * WGM, gsz = (nM - fm) < WGM ? (nM - fm) : WGM;
        u.pm = fm + ((wgid % nig) % gsz); u.pn = (wgid % nig) / gsz; return true;
    }
    __device__ __forceinline__ void a_ready(const Unit&) const {}
    __device__ __forceinline__ void done(const Unit&) const {}
};
typedef float f32x2_c __attribute__((ext_vector_type(2))); typedef __bf16 bf16x2_c __attribute__((ext_vector_type(2)));
__device__ __forceinline__ unsigned cvt_pk_bf16(float lo, float hi) { const f32x2_c v = {lo, hi}; return __builtin_bit_cast(unsigned, __builtin_convertvector(v, bf16x2_c)); }
template <class Epi, class Sched, bool STAMP = false>
__device__ __forceinline__ void gemm_phase(PG8_LAS unsigned char* lds, const Gemm g, const Sched& S, const Epi& E, unsigned long long* stamps) {
    int tid = threadIdx.x; asm volatile("" : "+v"(tid)); const int wid = __builtin_amdgcn_readfirstlane(tid >> 6), lane = tid & 63, wr = wid >> 2, wc = wid & 3, fr = lane & 15, fq = lane >> 4;
    const int K = g.K, nt = K / BK;
    int ts_lo = 0, ts_hi = 0, nts = 0; const unsigned long long rt_entry = STAMP ? (unsigned long long)wall_clock64() : 0ull;
#define PG8_STAMP() do { if (STAMP && wid == 0 && nts < 64) { const unsigned long long _c = (unsigned long long)clock64(); \
        ts_lo = (lane == nts) ? (int)(unsigned)_c : ts_lo; ts_hi = (lane == nts) ? (int)(unsigned)(_c >> 32) : ts_hi; ++nts; } } while (0)
    PG8_STAMP();
    unsigned voffA[2], voffB[2];
#pragma unroll
    for (int i = 0; i < 2; ++i) { int R, C; stage_rc(tid * 16 + i * 8192, R, C); const int Rb = Epi::PERM ? ((R & ~31) + perm32(R & 31)) : R;
        voffA[i] = (unsigned)(R * K + C) * 2u; voffB[i] = (unsigned)(Rb * K + C) * 2u; }
    const size_t kstep = (size_t)(BK * 2);
    const size_t hstep = (size_t)HALF * K * 2;
    const size_t tstep = 2 * hstep;
    const unsigned ldsw = (unsigned)wid * 1024u;
    const int aoff = lds_byte(wr * 64 + fr, fq * 8), boff = lds_byte(wc * 32 + fr, fq * 8);
#define PG8_SA(b, h) (((b) * 2 + (h)) * HTB)
#define PG8_SB(b, h) ((4 + (b) * 2 + (h)) * HTB)
#define PG8_STAGE(bufoff, gbase, voff) do { _Pragma("unroll") for (int _i = 0; _i < 2; ++_i) \
        __builtin_amdgcn_global_load_lds((const unsigned*)((const char*)(gbase) + (voff)[_i]), (PG8_LAS unsigned*)(lds + (bufoff) + ldsw + _i * 8192), 16, 0, 0); } while (0)
#define PG8_LDA(dst, b, h) do { _Pragma("unroll") for (int m = 0; m < 4; ++m) _Pragma("unroll") for (int k = 0; k < 2; ++k) dst[m][k] = *(const PG8_LAS bf16x8*)(lds + PG8_SA(b, h) + aoff + m * 2048 + k * 1024); } while (0)
#define PG8_LDB(dst, b, h) do { _Pragma("unroll") for (int n = 0; n < 2; ++n) _Pragma("unroll") for (int k = 0; k < 2; ++k) dst[n][k] = *(const PG8_LAS bf16x8*)(lds + PG8_SB(b, h) + boff + n * 2048 + k * 1024); } while (0)
#define PG8_MMA(ai, bj, At, Bt) do { __builtin_amdgcn_s_setprio(1); _Pragma("unroll") for (int m = 0; m < 4; ++m) _Pragma("unroll") for (int n = 0; n < 2; ++n) _Pragma("unroll") for (int k = 0; k < 2; ++k) \
        acc[ai][bj][m][n] = __builtin_amdgcn_mfma_f32_16x16x32_bf16(Bt[n][k], At[m][k], acc[ai][bj][m][n], 0, 0, 0); __builtin_amdgcn_s_setprio(0); } while (0)
#define PG8_WAIT_V(n) asm volatile("s_waitcnt vmcnt(" #n ")" ::: "memory")
#define PG8_WAIT_L(n) asm volatile("s_waitcnt lgkmcnt(" #n ")" ::: "memory")
#define PG8_BAR __builtin_amdgcn_s_barrier()
#define PG8_SCHED __builtin_amdgcn_sched_barrier(0)
    Unit cur, nxt; int ui = 0;
    if (!S.next(0, cur)) return;
    f32x4 acc[2][2][4][2];
#pragma unroll
    for (int a = 0; a < 2; ++a)
#pragma unroll
        for (int b = 0; b < 2; ++b)
#pragma unroll
            for (int m = 0; m < 4; ++m)
#pragma unroll
                for (int n = 0; n < 2; ++n) acc[a][b][m][n] = (f32x4){0.f, 0.f, 0.f, 0.f};
    bf16x8 At[4][2], B0[2][2], B1[2][2];
    const char* cA = (const char*)g.A + (size_t)cur.pm * tstep; const char* cB = (const char*)g.Bt + (size_t)cur.pn * tstep;
    S.a_ready(cur);
    PG8_STAGE(PG8_SB(0, 0), cB, voffB); PG8_STAGE(PG8_SA(0, 0), cA, voffA); PG8_STAGE(PG8_SB(0, 1), cB + hstep, voffB); PG8_STAGE(PG8_SA(0, 1), cA + hstep, voffA);
    if (wr == 1) PG8_BAR;
    PG8_WAIT_V(4); PG8_BAR;
    PG8_STAGE(PG8_SB(1, 0), cB + kstep, voffB); PG8_STAGE(PG8_SA(1, 0), cA + kstep, voffA); PG8_STAGE(PG8_SB(1, 1), cB + hstep + kstep, voffB);
    PG8_WAIT_V(6); PG8_BAR;
    PG8_STAMP();
    for (;;) {
        const bool has_next = S.next(ui + 1, nxt);
        const char* nA = has_next ? (const char*)g.A + (size_t)nxt.pm * tstep : cA; const char* nB = has_next ? (const char*)g.Bt + (size_t)nxt.pn * tstep : cB;
        int t = 0;
        for (int seg = 0; seg < (Epi::HOOK_T >= 0 ? 2 : 1); ++seg) {
        const int tend = (Epi::HOOK_T >= 0 && seg == 0) ? Epi::HOOK_T : nt;
        for (; t < tend; t += 2) {
            const bool last = (t == nt - 2);
            const char* a1 = cA + (size_t)(t + 1) * kstep;
            const char* a2 = last ? nA : cA + (size_t)(t + 2) * kstep; const char* b2 = last ? nB : cB + (size_t)(t + 2) * kstep;
            const char* a3 = a2 + kstep; const char* b3 = b2 + kstep;
            if (last && has_next) S.a_ready(nxt);
            PG8_LDB(B0, 0, 0); PG8_SCHED; PG8_LDA(At, 0, 0); PG8_STAGE(PG8_SA(1, 1), a1 + hstep, voffA);
            PG8_WAIT_L(8); PG8_BAR; PG8_WAIT_L(0); PG8_MMA(0, 0, At, B0); PG8_BAR; PG8_SCHED;
            PG8_LDB(B1, 0, 1); PG8_STAGE(PG8_SB(0, 0), b2, voffB);
            PG8_BAR; PG8_WAIT_L(0); PG8_MMA(0, 1, At, B1); PG8_BAR;
            PG8_LDA(At, 0, 1); PG8_STAGE(PG8_SA(0, 0), a2, voffA);
            PG8_BAR; PG8_WAIT_L(0); PG8_MMA(1, 0, At, B0); PG8_BAR; PG8_SCHED;
            PG8_STAGE(PG8_SB(0, 1), b2 + hstep, voffB);
            PG8_WAIT_V(6); PG8_BAR; PG8_MMA(1, 1, At, B1); PG8_BAR;
            PG8_LDB(B0, 1, 0); PG8_SCHED; PG8_LDA(At, 1, 0); PG8_STAGE(PG8_SA(0, 1), a2 + hstep, voffA);
            PG8_WAIT_L(8); PG8_BAR; PG8_WAIT_L(0); PG8_MMA(0, 0, At, B0); PG8_BAR; PG8_SCHED;
            PG8_LDB(B1, 1, 1); PG8_STAGE(PG8_SB(1, 0), b3, voffB);
            PG8_BAR; PG8_WAIT_L(0); PG8_MMA(0, 1, At, B1); PG8_BAR;
            PG8_LDA(At, 1, 1); PG8_STAGE(PG8_SA(1, 0), a3, voffA);
            PG8_BAR; PG8_WAIT_L(0); PG8_MMA(1, 0, At, B0); PG8_BAR; PG8_SCHED;
            PG8_STAGE(PG8_SB(1, 1), b3 + hstep, voffB);
            PG8_WAIT_V(6); PG8_BAR; PG8_MMA(1, 1, At, B1); PG8_BAR;
        }
        if constexpr (Epi::HOOK_T >= 0) { if (seg == 0) E.hook(acc, cur, wr, wc, fr, fq); }
        }
        PG8_STAMP();
        if constexpr (!Epi::AFTER_DRAIN) { E(acc, cur, wr, wc, fr, fq); S.done(cur); }
        PG8_STAMP();
        if (!has_next) break;
#pragma unroll
        for (int a = 0; a < 2; ++a)
#pragma unroll
            for (int b = 0; b < 2; ++b)
#pragma unroll
                for (int m = 0; m < 4; ++m)
#pragma unroll
                    for (int n = 0; n < 2; ++n) acc[a][b][m][n] = (f32x4){0.f, 0.f, 0.f, 0.f};
        cur = nxt; cA = nA; cB = nB; ++ui;
    }
    PG8_WAIT_V(0);
    if (wr == 0) PG8_BAR;
    PG8_BAR;
    if constexpr (Epi::AFTER_DRAIN) { E.fused(acc, cur, wr, wc, fr, fq, lds, wid, lane); S.done(cur); }
    PG8_STAMP();
    if (STAMP && wid == 0) { stamps[lane] = lane < nts ? (((unsigned long long)(unsigned)ts_hi << 32) | (unsigned)ts_lo) : 0ull;
        if (lane == 62) stamps[62] = rt_entry; if (lane == 63) stamps[63] = (unsigned long long)wall_clock64(); }
#undef PG8_STAMP
#undef PG8_SA
#undef PG8_SB
#undef PG8_STAGE
#undef PG8_LDA
#undef PG8_LDB
#undef PG8_MMA
#undef PG8_WAIT_V
#undef PG8_WAIT_L
#undef PG8_BAR
#undef PG8_SCHED
}
}

#define LAS PG8_LAS
using pg8::bf16x8; using pg8::f32x4; using pg8::u32x4; using pg8::Unit; using pg8::cvt_pk_bf16;
typedef unsigned short u16;
typedef unsigned u32x2 __attribute__((ext_vector_type(2)));

constexpr int M = 33792, MP = 32768, DM = 2048, DFF = 5504, ZN = 13568, NUP = 11008;
constexpr int LDS_BYTES = 147456;
constexpr float DN_ALPHA = 1.189207115002721f;
constexpr size_t O_Y = 0, O_KP = 69206016, O_VP = 77594624, O_SP = 85983232, O_CP = 94371840, O_KS = 94547968, O_VS = 95596544, O_SS = 96645120, O_CS = 113422336;
constexpr size_t SZ_R1 = (size_t)M * 1024 * 2, SZ_R2 = (size_t)M * 2048 * 2;
constexpr size_t W_IN = 0, W_BRG = W_IN + (size_t)ZN * 2048 * 2, W_BRA = W_BRG + (size_t)2048 * 2048 * 2, W_OUT = W_BRA + (size_t)2048 * 1024 * 2,
                 W_UP = W_OUT + (size_t)2048 * 2048 * 2, W_DN = W_UP + (size_t)NUP * 2048 * 2, W_END = W_DN + (size_t)2048 * DFF * 2;
constexpr size_t R_QG = W_END, R_KG = R_QG + SZ_R1, R_VG = R_KG + SZ_R1, R_RG = R_VG + SZ_R2, R_QA = R_RG + SZ_R2, R_KA = R_QA + SZ_R1, R_VAT = R_KA + SZ_R1,
                 R_MG = R_VAT + (size_t)16 * 8 * 128 * 2048 * 2, R_MA = R_MG + SZ_R2, R_ALO = R_MA + SZ_R2, R_DEC = R_ALO + (size_t)M * 16 * 4, WS_END = R_DEC + (size_t)544 * 1024 * 4;
constexpr size_t R_T1 = R_QG, R_T = R_RG, R_HB = R_QG, R_SIDE = R_VG, R_AACT = R_RG;
constexpr int NSEG = M / 64;
constexpr size_t SZ_SIDE = (size_t)NSEG * 2 * DFF * 4;

struct Params {
    const float *x_prompt, *x_sample, *cache_k, *cache_v, *state_gla, *state_conv, *w_in, *gate_up, *gate_b, *norm_g, *rel_bias, *merge_b, *w_brg, *w_bra, *w_out,
        *ln1_g, *ln1_b, *w_up, *conv_w, *conv_b, *w_dn, *ln2_g, *ln2_b;
    float* out; unsigned char* ws;
};

__device__ __forceinline__ int opaque_tid() { int t = threadIdx.x; asm volatile("" : "+v"(t)); return t; }
__device__ __forceinline__ float bf_lo(unsigned w) { return __uint_as_float(w << 16); }
__device__ __forceinline__ float bf_hi(unsigned w) { return __uint_as_float(w & 0xffff0000u); }
__device__ __forceinline__ bf16x8 as_bf8(u32x4 v) { return __builtin_bit_cast(bf16x8, v); }
__device__ __forceinline__ f32x4 mfma16(bf16x8 a, bf16x8 b, f32x4 c) { return __builtin_amdgcn_mfma_f32_16x16x32_bf16(a, b, c, 0, 0, 0); }
__device__ __forceinline__ u16 f2bf(float f) { return (u16)(cvt_pk_bf16(f, 0.f) & 0xffffu); }
__device__ __forceinline__ float sigmoidf_(float x) { return __builtin_amdgcn_rcpf(1.f + __expf(-x)); }
__device__ __forceinline__ float gelu_tanh(float x) { const float t = 1.5957691216057308f * (x + 0.044715f * x * x * x); return x * __builtin_amdgcn_rcpf(1.f + __expf(-t)); }
__device__ __forceinline__ float wave_sum(float v) {
#pragma unroll
    for (int o = 1; o < 64; o <<= 1) v += __shfl_xor(v, o);
    return v;
}
__device__ __forceinline__ u32x4 pack8(f32x4 a, f32x4 b) { u32x4 w; w.x = cvt_pk_bf16(a[0], a[1]); w.y = cvt_pk_bf16(a[2], a[3]); w.z = cvt_pk_bf16(b[0], b[1]); w.w = cvt_pk_bf16(b[2], b[3]); return w; }

template <class Map>
__device__ __forceinline__ void transpose_mat(const float* W, int K, int Nsrc, u16* WT, int Ndst, Map map, LAS float* scr, int gw, int NGW, int lane, int ldd = 0, int coff = 0) {
    if (ldd == 0) ldd = K;
    const int nblk = Ndst / 32, nitems = (K / 64) * nblk;
    const int c4 = lane & 7, kr = lane >> 3;
    f32x4 v[8];
#define TM_LOAD(itx) do { const int kb_ = (itx) / nblk, nb_ = (itx) % nblk; const int sc_ = map(32 * nb_ + 4 * c4); const float* wp_ = W + (size_t)(64 * kb_ + kr) * Nsrc + (sc_ >= 0 ? sc_ : 0); \
        _Pragma("unroll") for (int i = 0; i < 8; ++i) v[i] = sc_ >= 0 ? *(const f32x4*)(wp_ + (size_t)(8 * i) * Nsrc) : (f32x4){0.f, 0.f, 0.f, 0.f}; } while (0)
    int it = gw;
    if (it < nitems) TM_LOAD(it);
    for (; it < nitems; it += NGW) {
        const int kb = it / nblk, nb = it % nblk, k0 = 64 * kb, n0 = 32 * nb;
#pragma unroll
        for (int i = 0; i < 8; ++i)
#pragma unroll
            for (int e = 0; e < 4; ++e) scr[(kr + 8 * i) * 33 + 4 * c4 + e] = v[i][e];
        if (it + NGW < nitems) TM_LOAD(it + NGW);
        __builtin_amdgcn_wave_barrier();
        const int c = lane & 7;
#pragma unroll
        for (int j = 0; j < 4; ++j) { const int n = (lane >> 3) + 8 * j; const LAS float* s = scr + (8 * c) * 33 + n;
            u32x4 o; o.x = cvt_pk_bf16(s[0 * 33], s[1 * 33]); o.y = cvt_pk_bf16(s[2 * 33], s[3 * 33]); o.z = cvt_pk_bf16(s[4 * 33], s[5 * 33]); o.w = cvt_pk_bf16(s[6 * 33], s[7 * 33]);
            *(u32x4*)(WT + (size_t)(n0 + n) * ldd + coff + k0 + 8 * c) = o; }
        __builtin_amdgcn_wave_barrier();
    }
#undef TM_LOAD
}
struct MapId { __device__ __forceinline__ int operator()(int n) const { return n; } };
struct MapIn { __device__ __forceinline__ int operator()(int n) const { return n < 6144 ? n : (n < 13312 ? n + 16 : (n < 13328 ? n - 13312 + 6144 : -1)); } };
struct MapUp { __device__ __forceinline__ int operator()(int n) const { const int pn = n >> 8, j = n & 255; return j < 128 ? 128 * pn + j : DFF + 128 * pn + (j - 128); } };

__device__ __forceinline__ void phase0(LAS unsigned char* lds, const Params& p) {
    const int tid = opaque_tid(), lane = tid & 63, w = tid >> 6;
    const int gw = blockIdx.x * 8 + w, NGW = gridDim.x * 8;
    LAS float* scr = (LAS float*)(lds + w * 8704);
    transpose_mat(p.w_in, 2048, 13328, (u16*)(p.ws + W_IN), ZN, MapIn(), scr, gw, NGW, lane);
    u16* xb = (u16*)p.out;
    const size_t n8 = (size_t)M * DM / 8, np8 = (size_t)MP * DM / 8;
    for (size_t i = (size_t)blockIdx.x * 512 + tid; i < n8; i += (size_t)gridDim.x * 512) {
        const float* s = i < np8 ? p.x_prompt + i * 8 : p.x_sample + (i - np8) * 8;
        const f32x4 a = *(const f32x4*)s, b = *(const f32x4*)(s + 4);
        *(u32x4*)(xb + i * 8) = pack8(a, b);
    }
}

__device__ __forceinline__ void phase0_rest(LAS unsigned char* lds, const Params& p, int widx, int nw) {
    const int tid = opaque_tid(), lane = tid & 63, w = tid >> 6;
    const int gw = widx * 8 + w, NGW = nw * 8;
    LAS float* scr = (LAS float*)(lds + w * 8704);
    transpose_mat(p.w_brg, 2048, 2048, (u16*)(p.ws + W_BRG), 2048, MapId(), scr, gw, NGW, lane, 3072, 1024);
    transpose_mat(p.w_bra, 1024, 2048, (u16*)(p.ws + W_BRG), 2048, MapId(), scr, gw, NGW, lane, 3072, 0);
    transpose_mat(p.w_out, 2048, 2048, (u16*)(p.ws + W_OUT), 2048, MapId(), scr, gw, NGW, lane);
    transpose_mat(p.w_up, 2048, NUP, (u16*)(p.ws + W_UP), NUP, MapUp(), scr, gw, NGW, lane);
}
__device__ __forceinline__ void phase0_dn(LAS unsigned char* lds, const Params& p, int widx, int nw) {
    const int tid = opaque_tid(), lane = tid & 63, w = tid >> 6;
    LAS float* scr = (LAS float*)(lds + w * 8704);
    transpose_mat(p.w_dn, DFF, 2048, (u16*)(p.ws + W_DN), 2048, MapId(), scr, widx * 8 + w, nw * 8, lane);
}

struct EpiZ {
    static constexpr bool PERM = true, AFTER_DRAIN = false; static constexpr int HOOK_T = -1;
    unsigned char* ws; float* out; const float* merge_b;
    __device__ __forceinline__ void operator()(const f32x4 (&acc)[2][2][4][2], const Unit& u, int wr, int wc, int fr, int fq) const {
        const int pn = u.pn, row0 = u.pm * 256 + wr * 64 + fr, colt = wc * 32 + 8 * fq;
        if (pn < 28 || (pn >= 36 && pn < 52)) {
            u16* base; int ld, c0; const float* bias = nullptr;
            if (pn < 4) { base = (u16*)(ws + R_QG); ld = 1024; c0 = pn * 256; }
            else if (pn < 8) { base = (u16*)(ws + R_KG); ld = 1024; c0 = (pn - 4) * 256; }
            else if (pn < 16) { base = (u16*)(ws + R_VG); ld = 2048; c0 = (pn - 8) * 256; }
            else if (pn < 24) { base = (u16*)(ws + R_RG); ld = 2048; c0 = (pn - 16) * 256; }
            else if (pn < 28) { base = (u16*)(ws + R_QA); ld = 1024; c0 = (pn - 24) * 256; }
            else if (pn < 44) { base = (u16*)(ws + R_MG); ld = 2048; c0 = (pn - 36) * 256; bias = merge_b; }
            else { base = (u16*)(ws + R_MA); ld = 2048; c0 = (pn - 44) * 256; bias = merge_b + 2048; }
            f32x4 bv[2][2];
#pragma unroll
            for (int bj = 0; bj < 2; ++bj)
#pragma unroll
                for (int n = 0; n < 2; ++n) bv[bj][n] = bias ? *(const f32x4*)(bias + c0 + bj * 128 + colt + 4 * n) : (f32x4){0.f, 0.f, 0.f, 0.f};
#pragma unroll
            for (int ai = 0; ai < 2; ++ai)
#pragma unroll
                for (int m = 0; m < 4; ++m) { u16* rowp = base + (size_t)(row0 + ai * 128 + m * 16) * ld + c0 + colt;
#pragma unroll
                    for (int bj = 0; bj < 2; ++bj) { f32x4 v0 = acc[ai][bj][m][0], v1 = acc[ai][bj][m][1];
                        if (bias) {
#pragma unroll
                            for (int j = 0; j < 4; ++j) { v0[j] = sigmoidf_(v0[j] + bv[bj][0][j]); v1[j] = sigmoidf_(v1[j] + bv[bj][1][j]); } }
                        __builtin_nontemporal_store(pack8(v0, v1), (u32x4*)(rowp + bj * 128)); } }
        } else if (pn < 36) {
            const bool isv = pn >= 32; const int c0 = (pn - (isv ? 32 : 28)) * 256;
            float* op = out + (isv ? O_VP : O_KP); float* os = out + (isv ? O_VS : O_KS);
            u16* kab = (u16*)(ws + R_KA); u16* vat = (u16*)(ws + R_VAT);
#pragma unroll
            for (int ai = 0; ai < 2; ++ai)
#pragma unroll
                for (int m = 0; m < 4; ++m) { const int row = row0 + ai * 128 + m * 16;
#pragma unroll
                    for (int bj = 0; bj < 2; ++bj) { const int c = c0 + bj * 128 + colt; const f32x4 v0 = acc[ai][bj][m][0], v1 = acc[ai][bj][m][1];
                        if (row < MP) { const int t = row & 2047, b = row >> 11;
                            if (t >= 1536) { float* d = op + ((size_t)(b * 512 + t - 1536)) * 1024 + c; *(f32x4*)d = v0; *(f32x4*)(d + 4) = v1; }
                            if (!isv) *(u32x4*)(kab + (size_t)row * 1024 + c) = pack8(v0, v1);
                            else { const int hh = c >> 7, d0 = c & 127; u16* vp = vat + ((size_t)((b * 8 + hh) * 128 + d0)) * 2048 + t;
#pragma unroll
                                for (int j = 0; j < 4; ++j) { vp[(size_t)j * 2048] = f2bf(v0[j]); vp[(size_t)(j + 4) * 2048] = f2bf(v1[j]); } }
                        } else { float* d = os + (size_t)(row - MP) * 1024 + c; *(f32x4*)d = v0; *(f32x4*)(d + 4) = v1; } } }
        } else {
            if (wc == 0 && fq < 2) { float* alo = (float*)(ws + R_ALO);
#pragma unroll
                for (int ai = 0; ai < 2; ++ai)
#pragma unroll
                    for (int m = 0; m < 4; ++m) { float* d = alo + (size_t)(row0 + ai * 128 + m * 16) * 16 + 8 * fq; *(f32x4*)d = acc[ai][0][m][0]; *(f32x4*)(d + 4) = acc[ai][0][m][1]; } }
        }
    }
};

struct EpiBr1 {
    static constexpr bool PERM = true, AFTER_DRAIN = false; static constexpr int HOOK_T = -1;
    const u16* gate; u16* t1;
    __device__ __forceinline__ void operator()(const f32x4 (&acc)[2][2][4][2], const Unit& u, int wr, int wc, int fr, int fq) const {
        const int row0 = u.pm * 256 + wr * 64 + fr, col0 = u.pn * 256 + wc * 32 + 8 * fq;
#pragma unroll
        for (int ai = 0; ai < 2; ++ai)
#pragma unroll
            for (int m = 0; m < 4; ++m) { const size_t ro = (size_t)(row0 + ai * 128 + m * 16) * 2048 + col0;
#pragma unroll
                for (int bj = 0; bj < 2; ++bj) { const u32x4 g = *(const u32x4*)(gate + ro + bj * 128); const f32x4 v0 = acc[ai][bj][m][0], v1 = acc[ai][bj][m][1];
                    const f32x4 o0 = {v0[0] * bf_lo(g.x), v0[1] * bf_hi(g.x), v0[2] * bf_lo(g.y), v0[3] * bf_hi(g.y)}, o1 = {v1[0] * bf_lo(g.z), v1[1] * bf_hi(g.z), v1[2] * bf_lo(g.w), v1[3] * bf_hi(g.w)};
                    *(u32x4*)(t1 + ro + bj * 128) = pack8(o0, o1); } }
    }
};
struct EpiBr2 {
    static constexpr bool PERM = true, AFTER_DRAIN = false; static constexpr int HOOK_T = -1;
    const u16* gate; const u16* t1; u16* t;
    __device__ __forceinline__ void operator()(const f32x4 (&acc)[2][2][4][2], const Unit& u, int wr, int wc, int fr, int fq) const {
        const int row0 = u.pm * 256 + wr * 64 + fr, col0 = u.pn * 256 + wc * 32 + 8 * fq;
#pragma unroll
        for (int ai = 0; ai < 2; ++ai)
#pragma unroll
            for (int m = 0; m < 4; ++m) { const size_t ro = (size_t)(row0 + ai * 128 + m * 16) * 2048 + col0;
#pragma unroll
                for (int bj = 0; bj < 2; ++bj) { const u32x4 g = *(const u32x4*)(gate + ro + bj * 128); const f32x4 v0 = acc[ai][bj][m][0], v1 = acc[ai][bj][m][1];
                    const u32x4 a = *(const u32x4*)(t1 + ro + bj * 128);
                    const f32x4 o0 = {bf_lo(a.x) + v0[0] * bf_lo(g.x), bf_hi(a.x) + v0[1] * bf_hi(g.x), bf_lo(a.y) + v0[2] * bf_lo(g.y), bf_hi(a.y) + v0[3] * bf_hi(g.y)};
                    const f32x4 o1 = {bf_lo(a.z) + v1[0] * bf_lo(g.z), bf_hi(a.z) + v1[1] * bf_hi(g.z), bf_lo(a.w) + v1[2] * bf_lo(g.w), bf_hi(a.w) + v1[3] * bf_hi(g.w)};
                    *(u32x4*)(t + ro + bj * 128) = pack8(o0, o1); } }
    }
};
struct EpiBr {
    static constexpr bool PERM = true, AFTER_DRAIN = false; static constexpr int HOOK_T = 16;
    const u16 *ga, *gb; u16* t;
    __device__ __forceinline__ void hook(f32x4 (&acc)[2][2][4][2], const Unit& u, int wr, int wc, int fr, int fq) const {
        unsigned base = (unsigned)(u.pm * 256 + wr * 64 + fr) * 2048u + (unsigned)(u.pn * 256 + wc * 32 + 8 * fq);
        asm volatile("" : "+v"(base));
#pragma unroll
        for (int ai = 0; ai < 2; ++ai)
#pragma unroll
            for (int m = 0; m < 4; ++m)
#pragma unroll
                for (int bj = 0; bj < 2; ++bj) { const unsigned ro = base + (unsigned)((ai * 128 + m * 16) * 2048 + bj * 128);
                    const u32x4 a = *(const u32x4*)(ga + ro), b = *(const u32x4*)(gb + ro);
                    const f32x4 r0 = {bf_lo(b.x) * __builtin_amdgcn_rcpf(bf_lo(a.x)), bf_hi(b.x) * __builtin_amdgcn_rcpf(bf_hi(a.x)), bf_lo(b.y) * __builtin_amdgcn_rcpf(bf_lo(a.y)), bf_hi(b.y) * __builtin_amdgcn_rcpf(bf_hi(a.y))};
                    const f32x4 r1 = {bf_lo(b.z) * __builtin_amdgcn_rcpf(bf_lo(a.z)), bf_hi(b.z) * __builtin_amdgcn_rcpf(bf_hi(a.z)), bf_lo(b.w) * __builtin_amdgcn_rcpf(bf_lo(a.w)), bf_hi(b.w) * __builtin_amdgcn_rcpf(bf_hi(a.w))};
                    acc[ai][bj][m][0] = acc[ai][bj][m][0] * r0; acc[ai][bj][m][1] = acc[ai][bj][m][1] * r1;
                    if (bj == 1 && m == 3) __builtin_amdgcn_sched_barrier(0); }
    }
    __device__ __forceinline__ void operator()(const f32x4 (&acc)[2][2][4][2], const Unit& u, int wr, int wc, int fr, int fq) const {
        const int row0 = u.pm * 256 + wr * 64 + fr, col0 = u.pn * 256 + wc * 32 + 8 * fq;
#pragma unroll
        for (int ai = 0; ai < 2; ++ai)
#pragma unroll
            for (int m = 0; m < 4; ++m) { const size_t ro = (size_t)(row0 + ai * 128 + m * 16) * 2048 + col0;
#pragma unroll
                for (int bj = 0; bj < 2; ++bj) { const u32x4 g = *(const u32x4*)(ga + ro + bj * 128); const f32x4 v0 = acc[ai][bj][m][0], v1 = acc[ai][bj][m][1];
                    const f32x4 o0 = {v0[0] * bf_lo(g.x), v0[1] * bf_hi(g.x), v0[2] * bf_lo(g.y), v0[3] * bf_hi(g.y)}, o1 = {v1[0] * bf_lo(g.z), v1[1] * bf_hi(g.z), v1[2] * bf_lo(g.w), v1[3] * bf_hi(g.w)};
                    *(u32x4*)(t + ro + bj * 128) = pack8(o0, o1); } }
    }
};
struct EpiOut {
    static constexpr bool PERM = true, AFTER_DRAIN = false; static constexpr int HOOK_T = -1;
    const float *xp, *xs; u16* dst;
    __device__ __forceinline__ void operator()(const f32x4 (&acc)[2][2][4][2], const Unit& u, int wr, int wc, int fr, int fq) const {
        const int row0 = u.pm * 256 + wr * 64 + fr, col0 = u.pn * 256 + wc * 32 + 8 * fq;
#pragma unroll
        for (int ai = 0; ai < 2; ++ai)
#pragma unroll
            for (int m = 0; m < 4; ++m) { const int row = row0 + ai * 128 + m * 16; const float* xr = row < MP ? xp + (size_t)row * 2048 : xs + (size_t)(row - MP) * 2048;
#pragma unroll
                for (int bj = 0; bj < 2; ++bj) { const int c = col0 + bj * 128; const f32x4 x0 = *(const f32x4*)(xr + c), x1 = *(const f32x4*)(xr + c + 4);
                    *(u32x4*)(dst + (size_t)row * 2048 + c) = pack8(x0 * DN_ALPHA + acc[ai][bj][m][0], x1 * DN_ALPHA + acc[ai][bj][m][1]); } }
    }
};
struct EpiDown {
    static constexpr bool PERM = true, AFTER_DRAIN = false; static constexpr int HOOK_T = -1;
    const u16* hb; u16* dst;
    __device__ __forceinline__ void operator()(const f32x4 (&acc)[2][2][4][2], const Unit& u, int wr, int wc, int fr, int fq) const {
        const int row0 = u.pm * 256 + wr * 64 + fr, col0 = u.pn * 256 + wc * 32 + 8 * fq;
#pragma unroll
        for (int ai = 0; ai < 2; ++ai)
#pragma unroll
            for (int m = 0; m < 4; ++m) { const size_t ro = (size_t)(row0 + ai * 128 + m * 16) * 2048 + col0;
#pragma unroll
                for (int bj = 0; bj < 2; ++bj) { const u32x4 hv = *(const u32x4*)(hb + ro + bj * 128);
                    const f32x4 h0 = {bf_lo(hv.x), bf_hi(hv.x), bf_lo(hv.y), bf_hi(hv.y)}, h1 = {bf_lo(hv.z), bf_hi(hv.z), bf_lo(hv.w), bf_hi(hv.w)};
                    *(u32x4*)(dst + ro + bj * 128) = pack8(h0 * DN_ALPHA + acc[ai][bj][m][0], h1 * DN_ALPHA + acc[ai][bj][m][1]); } }
    }
};
struct EpiUp {
    static constexpr bool PERM = true, AFTER_DRAIN = false; static constexpr int HOOK_T = -1;
    const float *conv_w, *conv_b, *state_conv; float* out; u16* a; float *uh, *uf, *gf;
    __device__ __forceinline__ void operator()(const f32x4 (&acc)[2][2][4][2], const Unit& u, int wr, int wc, int fr, int fq) const {
        const int lane = fq * 16 + fr, ch = u.pn * 128 + wc * 32 + 8 * fq;
        const int src1 = (lane & 48) | ((fr + 15) & 15), src2 = (lane & 48) | ((fr + 14) & 15);
        f32x4 w0[2], w1[2], w2[2], cb[2];
#pragma unroll
        for (int n = 0; n < 2; ++n) { w0[n] = *(const f32x4*)(conv_w + ch + 4 * n); w1[n] = *(const f32x4*)(conv_w + DFF + ch + 4 * n); w2[n] = *(const f32x4*)(conv_w + 2 * DFF + ch + 4 * n); cb[n] = *(const f32x4*)(conv_b + ch + 4 * n); }
        const bool prompt = u.pm < 128;
#pragma unroll
        for (int ai = 0; ai < 2; ++ai) {
            const int seg = u.pm * 4 + ai * 2 + wr;
#pragma unroll
            for (int m = 0; m < 4; ++m) {
                const int row = seg * 64 + m * 16 + fr;
                f32x4 p1[2], p2[2];
#pragma unroll
                for (int n = 0; n < 2; ++n)
#pragma unroll
                    for (int j = 0; j < 4; ++j) {
                        const float cur = acc[ai][0][m][n][j], prv = m > 0 ? acc[ai][0][m > 0 ? m - 1 : 0][n][j] : 0.f;
                        p1[n][j] = __int_as_float(__builtin_amdgcn_update_dpp(0, __float_as_int(fr == 15 ? prv : cur), 0x121, 0xf, 0xf, false));
                        p2[n][j] = __int_as_float(__builtin_amdgcn_update_dpp(0, __float_as_int(fr >= 14 ? prv : cur), 0x122, 0xf, 0xf, false)); }
                bool fix = false;
                if (prompt) {
                    const int t = row & 2047, b = row >> 11;
                    if (m == 0 && fr < 2) { fix = true; float* d = uf + ((size_t)seg * 2 + fr) * DFF + ch; float* e = gf + ((size_t)seg * 2 + fr) * DFF + ch;
                        *(f32x4*)d = acc[ai][0][m][0]; *(f32x4*)(d + 4) = acc[ai][0][m][1]; *(f32x4*)e = acc[ai][1][m][0]; *(f32x4*)(e + 4) = acc[ai][1][m][1]; }
                    if (m == 3 && fr >= 14) { float* d = uh + ((size_t)seg * 2 + (fr - 14)) * DFF + ch; *(f32x4*)d = acc[ai][0][m][0]; *(f32x4*)(d + 4) = acc[ai][0][m][1]; }
                    if (t >= 2046) { float* d = out + O_CP + ((size_t)b * 2 + (t - 2046)) * DFF + ch; *(f32x4*)d = acc[ai][0][m][0]; *(f32x4*)(d + 4) = acc[ai][0][m][1]; }
                } else {
                    const int rs = row - MP, ts = rs & 31, bs = rs >> 5;
                    if (ts < 2) { const float* s1 = state_conv + ((size_t)bs * 2 + 1) * DFF + ch; const float* s0 = state_conv + ((size_t)bs * 2) * DFF + ch;
                        const f32x4 a1 = *(const f32x4*)s1, b1 = *(const f32x4*)(s1 + 4), a0 = *(const f32x4*)s0, b0 = *(const f32x4*)(s0 + 4);
                        if (ts == 0) { p1[0] = a1; p1[1] = b1; p2[0] = a0; p2[1] = b0; } else { p2[0] = a1; p2[1] = b1; } }
                    if (ts >= 30) { float* d = out + O_CS + ((size_t)bs * 2 + (ts - 30)) * DFF + ch; *(f32x4*)d = acc[ai][0][m][0]; *(f32x4*)(d + 4) = acc[ai][0][m][1]; }
                }
                if (!fix) {
                    f32x4 r[2];
#pragma unroll
                    for (int n = 0; n < 2; ++n)
#pragma unroll
                        for (int j = 0; j < 4; ++j) { const float uc = cb[n][j] + w0[n][j] * p2[n][j] + w1[n][j] * p1[n][j] + w2[n][j] * acc[ai][0][m][n][j]; r[n][j] = gelu_tanh(uc) * acc[ai][1][m][n][j]; }
                    __builtin_nontemporal_store(pack8(r[0], r[1]), (u32x4*)(a + (size_t)row * DFF + ch));
                }
            }
        }
    }
};

__device__ __forceinline__ void phase_fixup(const Params& p) {
    const float* uh = (const float*)(p.ws + R_SIDE); const float* uf = uh + SZ_SIDE / 4; const float* gf = uf + SZ_SIDE / 4; u16* a = (u16*)(p.ws + R_AACT);
    const int total = 512 * 2 * DFF;
    for (int i = blockIdx.x * 512 + threadIdx.x; i < total; i += gridDim.x * 512) {
        const int ch = i % DFF, sj = i / DFF, j = sj & 1, seg = sj >> 1, row = seg * 64 + j, t = row & 2047;
        const float u0 = uf[((size_t)seg * 2 + j) * DFF + ch], g0 = gf[((size_t)seg * 2 + j) * DFF + ch];
        float p1, p2;
        if (j == 0) { p1 = t == 0 ? 0.f : uh[((size_t)(seg - 1) * 2 + 1) * DFF + ch]; p2 = t == 0 ? 0.f : uh[((size_t)(seg - 1) * 2) * DFF + ch]; }
        else { p1 = uf[((size_t)seg * 2) * DFF + ch]; p2 = t == 1 ? 0.f : uh[((size_t)(seg - 1) * 2 + 1) * DFF + ch]; }
        const float uc = p.conv_b[ch] + p.conv_w[ch] * p2 + p.conv_w[DFF + ch] * p1 + p.conv_w[2 * DFF + ch] * u0;
        a[(size_t)row * DFF + ch] = f2bf(gelu_tanh(uc) * g0);
    }
}

__device__ __forceinline__ float logsig(float x) { return fminf(x, 0.f) - __logf(1.f + __expf(-fabsf(x))); }

__device__ __forceinline__ void gla_prep_unit(LAS unsigned char* lds, const Params& p, int pu, float (&gu0)[16], float (&gu1)[16], float& gb0, float& gb1, int& hcur, bool dry = false) {
    const int tid = opaque_tid();
    int b, h, r0, valid, brow;
    if (pu < 2048) { h = pu & 3; const int n = (pu >> 2) & 31; b = pu >> 7; r0 = b * 2048 + 64 * n; valid = 64; brow = b * 32 + n; }
    else { const int ps = pu - 2048; h = ps & 3; b = ps >> 2; r0 = MP + 32 * b; valid = 32; brow = 512 + b; }
    LAS float* ALO = (LAS float*)(lds); LAS float* CS = (LAS float*)(lds + 4096);
    u16* qg = (u16*)(p.ws + R_QG); u16* kg = (u16*)(p.ws + R_KG); const float* alo = (const float*)(p.ws + R_ALO); float* decb = (float*)(p.ws + R_DEC);
    const int kc = tid & 127, rg = tid >> 7;
    if (h != hcur) { hcur = h;
#pragma unroll
        for (int i = 0; i < 16; ++i) { gu0[i] = p.gate_up[i * 1024 + h * 256 + 2 * kc]; gu1[i] = p.gate_up[i * 1024 + h * 256 + 2 * kc + 1]; }
        gb0 = p.gate_b[h * 256 + 2 * kc]; gb1 = p.gate_b[h * 256 + 2 * kc + 1]; }
    if (tid < 256) { const int t = tid >> 2, c4 = tid & 3; const int row = min(r0 + t, M - 1); *(LAS f32x4*)(ALO + t * 16 + 4 * c4) = *(const f32x4*)(alo + (size_t)row * 16 + 4 * c4); }
    __syncthreads();
    float la0[16], la1[16]; float run0 = 0.f, run1 = 0.f;
#pragma unroll
    for (int rr = 0; rr < 16; ++rr) { const int t = 16 * rg + rr; float x0 = gb0, x1 = gb1;
#pragma unroll
        for (int i4 = 0; i4 < 4; ++i4) { const f32x4 a = *(const LAS f32x4*)(ALO + t * 16 + 4 * i4);
#pragma unroll
            for (int e = 0; e < 4; ++e) { x0 += a[e] * gu0[4 * i4 + e]; x1 += a[e] * gu1[4 * i4 + e]; } }
        if (t < valid) { run0 += logsig(x0) * 0.0625f; run1 += logsig(x1) * 0.0625f; }
        la0[rr] = run0; la1[rr] = run1; }
    CS[rg * 256 + 2 * kc] = run0; CS[rg * 256 + 2 * kc + 1] = run1;
    __syncthreads();
    float pre0 = 0.f, pre1 = 0.f, tot0 = 0.f, tot1 = 0.f;
#pragma unroll
    for (int g = 0; g < 4; ++g) { const float c0 = CS[g * 256 + 2 * kc], c1 = CS[g * 256 + 2 * kc + 1]; tot0 += c0; tot1 += c1; if (g < rg) { pre0 += c0; pre1 += c1; } }
    if (rg == 0) { decb[(size_t)brow * 1024 + h * 256 + 2 * kc] = __expf(tot0); decb[(size_t)brow * 1024 + h * 256 + 2 * kc + 1] = __expf(tot1); }
#pragma unroll
    for (int rr = 0; rr < 16; ++rr) { const int t = 16 * rg + rr;
        if (t < valid) { const size_t o = (size_t)(r0 + t) * 1024 + h * 256 + 2 * kc; const unsigned qr = *(const unsigned*)(qg + o), kr = *(const unsigned*)(kg + o);
            const float b0 = la0[rr] + pre0, b1 = la1[rr] + pre1;
            u16* qd = dry ? (u16*)p.out : qg; u16* kd = dry ? (u16*)p.out + (size_t)M * 1024 : kg;
            *(unsigned*)(qd + o) = cvt_pk_bf16(bf_lo(qr) * 0.0625f * __expf(b0), bf_hi(qr) * 0.0625f * __expf(b1));
            *(unsigned*)(kd + o) = cvt_pk_bf16(bf_lo(kr) * __expf(-b0), bf_hi(kr) * __expf(-b1)); } }
    __syncthreads();
}

__device__ __forceinline__ void gla_unit(LAS unsigned char* lds, const Params& p, int u) {
    const int tid = opaque_tid(), lane = tid & 63, w = __builtin_amdgcn_readfirstlane(tid >> 6), r = lane & 15, q = lane >> 4;
    const bool smp = u >= 256; const int uu = smp ? u - 256 : u;
    const int pr = smp ? (uu >> 2) : ((uu & 7) + 8 * (uu >> 5)), vs = smp ? (uu & 3) : ((uu >> 3) & 3);
    const int b = pr >> 2, h = pr & 3;
    const int row_base = smp ? MP + b * 32 : b * 2048, nblk = smp ? 1 : 32, valid = smp ? 32 : 64;
    LAS u16* QT = (LAS u16*)(lds); LAS u16* KT = (LAS u16*)(lds + 33792); LAS u16* KTT = (LAS u16*)(lds + 67584); LAS u16* VT = (LAS u16*)(lds + 104448); LAS u16* PP = (LAS u16*)(lds + 122880);
    LAS float* DEC = (LAS float*)(lds + 140288);
    const u16* qg = (const u16*)(p.ws + R_QG); const u16* kg = (const u16*)(p.ws + R_KG); const u16* vg = (const u16*)(p.ws + R_VG); const float* decb = (const float*)(p.ws + R_DEC);
    u16* og = (u16*)p.out + 1024;
    f32x4 S[16];
    const size_t sbase_u = ((size_t)(b * 4 + h) * 256) * 512 + vs * 128 + 16 * w;
    const int soff = 4 * q * 512 + r;
#pragma unroll
    for (int i = 0; i < 16; ++i) {
#pragma unroll
        for (int j = 0; j < 4; ++j) S[i][j] = smp ? (p.state_gla + sbase_u)[soff + (16 * i + j) * 512] : 0.f;
        __builtin_amdgcn_sched_barrier(0); }
    u32x4 pv[2], pq[4], pk[4]; f32x4 pdec = {0.f, 0.f, 0.f, 0.f};
#define GLA_LOAD(nn) do { const int r0_ = row_base + 64 * (nn), brow_ = smp ? 512 + b : b * 32 + (nn); \
        if (tid < 64) pdec = *(const f32x4*)(decb + (size_t)brow_ * 1024 + h * 256 + 4 * tid); \
        _Pragma("unroll") for (int i = 0; i < 2; ++i) { const int id = tid + 512 * i, s_ = id & 63, c8 = id >> 6; pv[i] = (u32x4){0u, 0u, 0u, 0u}; \
            if (s_ < valid) pv[i] = *(const u32x4*)(vg + (size_t)(r0_ + s_) * 2048 + h * 512 + vs * 128 + 8 * c8); } \
        _Pragma("unroll") for (int i = 0; i < 4; ++i) { const int id = tid + 512 * i, s_ = id & 63, c8 = id >> 6; pq[i] = (u32x4){0u, 0u, 0u, 0u}; pk[i] = (u32x4){0u, 0u, 0u, 0u}; \
            if (s_ < valid) { const size_t o_ = (size_t)(r0_ + s_) * 1024 + h * 256 + 8 * c8; pq[i] = *(const u32x4*)(qg + o_); pk[i] = *(const u32x4*)(kg + o_); } } } while (0)
    GLA_LOAD(0);
    for (int n = 0; n < nblk; ++n) {
        const int r0 = row_base + 64 * n;
        if (tid < 64) *(LAS f32x4*)(DEC + 4 * tid) = pdec;
#pragma unroll
        for (int i = 0; i < 2; ++i) { const int id = tid + 512 * i, s = id & 63, c8 = id >> 6; const u32x4 v = pv[i];
#pragma unroll
            for (int jj = 0; jj < 4; ++jj) { VT[(8 * c8 + 2 * jj) * 72 + s] = (u16)(v[jj] & 0xffffu); VT[(8 * c8 + 2 * jj + 1) * 72 + s] = (u16)(v[jj] >> 16); } }
#pragma unroll
        for (int i = 0; i < 4; ++i) { const int id = tid + 512 * i, s = id & 63, c8 = id >> 6; const u32x4 qv = pq[i], kv = pk[i];
            *(LAS u32x4*)(QT + s * 264 + 8 * c8) = qv; *(LAS u32x4*)(KT + s * 264 + 8 * c8) = kv;
#pragma unroll
            for (int jj = 0; jj < 4; ++jj) { KTT[(8 * c8 + 2 * jj) * 72 + s] = (u16)(kv[jj] & 0xffffu); KTT[(8 * c8 + 2 * jj + 1) * 72 + s] = (u16)(kv[jj] >> 16); } }
        __syncthreads();
        if (n + 1 < nblk) GLA_LOAD(n + 1);
        { const int mt = w >> 1;
#pragma unroll
          for (int tt = 0; tt < 2; ++tt) { const int nt = 2 * (w & 1) + tt; f32x4 c = {0.f, 0.f, 0.f, 0.f};
              if (nt <= mt) { bf16x8 fa[8], fb[8];
#pragma unroll
                  for (int ks = 0; ks < 8; ++ks) { fa[ks] = *(const LAS bf16x8*)(QT + (16 * mt + r) * 264 + 32 * ks + 8 * q); fb[ks] = *(const LAS bf16x8*)(KT + (16 * nt + r) * 264 + 32 * ks + 8 * q); }
                  __builtin_amdgcn_sched_barrier(0);
#pragma unroll
                  for (int ks = 0; ks < 8; ++ks) c = mfma16(fa[ks], fb[ks], c); }
#pragma unroll
              for (int j = 0; j < 4; ++j) { const int t = 16 * mt + 4 * q + j, s = 16 * nt + r; PP[t * 72 + s] = f2bf(s <= t ? c[j] : 0.f); } } }
        f32x4 oacc[4];
#pragma unroll
        for (int mt = 0; mt < 4; ++mt) oacc[mt] = (f32x4){0.f, 0.f, 0.f, 0.f};
#pragma unroll
        for (int p2 = 0; p2 < 4; ++p2) { u32x2 a0[2][4], a1[2][4];
#pragma unroll
            for (int e = 0; e < 2; ++e)
#pragma unroll
                for (int mt = 0; mt < 4; ++mt) { const int pp = 2 * p2 + e; a0[e][mt] = *(const LAS u32x2*)(QT + (16 * mt + r) * 264 + 32 * pp + 4 * q); a1[e][mt] = *(const LAS u32x2*)(QT + (16 * mt + r) * 264 + 32 * pp + 16 + 4 * q); }
            __builtin_amdgcn_sched_barrier(0);
#pragma unroll
            for (int e = 0; e < 2; ++e) { const int pp = 2 * p2 + e;
                u32x4 bw; bw.x = cvt_pk_bf16(S[2 * pp][0], S[2 * pp][1]); bw.y = cvt_pk_bf16(S[2 * pp][2], S[2 * pp][3]); bw.z = cvt_pk_bf16(S[2 * pp + 1][0], S[2 * pp + 1][1]); bw.w = cvt_pk_bf16(S[2 * pp + 1][2], S[2 * pp + 1][3]);
#pragma unroll
                for (int mt = 0; mt < 4; ++mt) { const u32x4 aw = {a0[e][mt].x, a0[e][mt].y, a1[e][mt].x, a1[e][mt].y}; oacc[mt] = mfma16(as_bf8(aw), as_bf8(bw), oacc[mt]); } }
            __builtin_amdgcn_sched_barrier(0); }
        __syncthreads();
        bf16x8 bv[2];
        { bf16x8 pa[4][2];
#pragma unroll
          for (int ks = 0; ks < 2; ++ks) bv[ks] = *(const LAS bf16x8*)(VT + (16 * w + r) * 72 + 32 * ks + 8 * q);
#pragma unroll
          for (int mt = 0; mt < 4; ++mt)
#pragma unroll
              for (int ks = 0; ks < 2; ++ks) pa[mt][ks] = *(const LAS bf16x8*)(PP + (16 * mt + r) * 72 + 32 * ks + 8 * q);
          __builtin_amdgcn_sched_barrier(0);
#pragma unroll
          for (int mt = 0; mt < 4; ++mt) {
#pragma unroll
              for (int ks = 0; ks < 2; ++ks) oacc[mt] = mfma16(pa[mt][ks], bv[ks], oacc[mt]); } }
#pragma unroll
        for (int mt = 0; mt < 4; ++mt)
#pragma unroll
            for (int j = 0; j < 4; ++j) { const int t = 16 * mt + 4 * q + j; if (t < valid) og[(size_t)(r0 + t) * 3072 + h * 512 + vs * 128 + 16 * w + r] = f2bf(oacc[mt][j]); }
#pragma unroll
        for (int g = 0; g < 4; ++g) { bf16x8 ka[4][2]; f32x4 dd[4];
#pragma unroll
            for (int e = 0; e < 4; ++e) { const int i = 4 * g + e;
#pragma unroll
                for (int ks = 0; ks < 2; ++ks) ka[e][ks] = *(const LAS bf16x8*)(KTT + (16 * i + r) * 72 + 32 * ks + 8 * q);
                dd[e] = *(const LAS f32x4*)(DEC + 16 * i + 4 * q); }
            __builtin_amdgcn_sched_barrier(0);
#pragma unroll
            for (int e = 0; e < 4; ++e) { const int i = 4 * g + e;
#pragma unroll
                for (int ks = 0; ks < 2; ++ks) S[i] = mfma16(ka[e][ks], bv[ks], S[i]); }
#pragma unroll
            for (int e = 0; e < 4; ++e) { const int i = 4 * g + e; S[i] = S[i] * dd[e]; }
            __builtin_amdgcn_sched_barrier(0); }
        __syncthreads();
    }
    float* so = p.out + (smp ? O_SS : O_SP);
#pragma unroll
    for (int i = 0; i < 16; ++i) {
#pragma unroll
        for (int j = 0; j < 4; ++j) (so + sbase_u)[soff + (16 * i + j) * 512] = S[i][j];
        __builtin_amdgcn_sched_barrier(0); }
}

#undef GLA_LOAD
template <bool smp>
__device__ __forceinline__ void attn_unit(LAS unsigned char* lds, const Params& p, int u, int& hprev, bool dry = false) {
    const int tid = opaque_tid(), lane = tid & 63, w = __builtin_amdgcn_readfirstlane(tid >> 6), r = lane & 15, q = lane >> 4;
    LAS u16* PL = (LAS u16*)lds; LAS float* RED = (LAS float*)(lds + 76800); LAS float* LS = RED + 512; LAS float* BT = LS + 512;
    int b, h, c = 0, nkc = 9, NT, rq0;
    if (!smp) { c = u & 31; h = (u >> 5) & 7; b = u >> 8; nkc = min(c, 8) + 1; NT = 4 * nkc; rq0 = b * 2048 + c * 64; }
    else { const int us = u - 4096; h = us & 7; b = us >> 3; NT = 34; rq0 = MP + b * 32; }
    const int tk0 = smp ? 0 : (c - (nkc - 1)) * 64;
    u16* qa = (u16*)(p.ws + R_QA); u16* oa = (u16*)p.out; (void)dry; const u16* kab = (const u16*)(p.ws + R_KA); const u16* vat = (const u16*)(p.ws + R_VAT);
    const float* ksn = p.out + O_KS; const float* vsn = p.out + O_VS;
    if (h != hprev) { __syncthreads(); if (tid < 257) BT[tid] = p.rel_bias[h * 257 + tid]; hprev = h; __syncthreads(); }
    LAS u16* QL = (LAS u16*)(lds + 82944);
#pragma unroll
    for (int i = 0; i < 2; ++i) { const int id = tid + 512 * i, row = id >> 4, c8 = id & 15; const int qrow = min(rq0 + row, M - 1);
        *(LAS u32x4*)(QL + row * 136 + 8 * c8) = *(const u32x4*)(qa + (size_t)qrow * 1024 + h * 128 + 8 * c8); }
    f32x4 sc[5][4];
#define ATT_KLOAD(dst, ii) do { const int ktc_ = min(w + 8 * (ii), NT - 1); \
        if (!smp) { const u16* kp_ = kab + (size_t)(b * 2048 + tk0 + 16 * ktc_ + r) * 1024 + h * 128 + 8 * q; \
            _Pragma("unroll") for (int ks = 0; ks < 4; ++ks) dst[ks] = *(const bf16x8*)(kp_ + 32 * ks); } \
        else { const int key_ = 16 * ktc_ + r; const float* kp_ = (key_ < 512 ? p.cache_k + ((size_t)(b * 512 + key_) * 8 + h) * 128 : ksn + ((size_t)(b * 32 + key_ - 512) * 8 + h) * 128) + 8 * q; \
            _Pragma("unroll") for (int ks = 0; ks < 4; ++ks) { const f32x4 x0_ = *(const f32x4*)(kp_ + 32 * ks), x1_ = *(const f32x4*)(kp_ + 32 * ks + 4); dst[ks] = as_bf8(pack8(x0_, x1_)); } } } while (0)
    bf16x8 kf[4], kn[4];
    ATT_KLOAD(kf, 0);
    __syncthreads();
#pragma unroll
    for (int i = 0; i < 5; ++i) { const int kt = w + 8 * i;
        const float neg = kt < NT ? 0.f : -1e30f;
        if (i < 4) ATT_KLOAD(kn, i + 1);
        f32x4 ca[4]; float bt[4][4];
#pragma unroll
        for (int rt = 0; rt < 4; ++rt) { ca[rt] = (f32x4){0.f, 0.f, 0.f, 0.f};
#pragma unroll
            for (int j = 0; j < 4; ++j) { const int qi = 16 * rt + 4 * q + j, key = 16 * kt + r; int rel = smp ? 512 + qi - key : qi - (key - 64 * (nkc - 1)); rel = max(-128, min(128, rel)); bt[rt][j] = BT[rel + 128]; } }
#pragma unroll
        for (int ks = 0; ks < 4; ++ks) { bf16x8 qfr[4];
#pragma unroll
            for (int rt = 0; rt < 4; ++rt) qfr[rt] = *(const LAS bf16x8*)(QL + (16 * rt + r) * 136 + 32 * ks + 8 * q);
            __builtin_amdgcn_sched_barrier(0);
#pragma unroll
            for (int rt = 0; rt < 4; ++rt) ca[rt] = mfma16(qfr[rt], kf[ks], ca[rt]); }
#pragma unroll
        for (int rt = 0; rt < 4; ++rt)
#pragma unroll
            for (int j = 0; j < 4; ++j) sc[i][rt][j] = ca[rt][j] * 0.08838834764831845f + bt[rt][j] + neg;
        __builtin_amdgcn_sched_barrier(0);
#pragma unroll
        for (int ks = 0; ks < 4; ++ks) kf[ks] = kn[ks]; }
#undef ATT_KLOAD
#pragma unroll
    for (int rt = 0; rt < 4; ++rt)
#pragma unroll
        for (int j = 0; j < 4; ++j) { float m = sc[0][rt][j];
#pragma unroll
            for (int i = 1; i < 5; ++i) m = fmaxf(m, sc[i][rt][j]);
#pragma unroll
            for (int o = 1; o < 16; o <<= 1) m = fmaxf(m, __shfl_xor(m, o));
            if (r == 0) RED[(16 * rt + 4 * q + j) * 8 + w] = m; }
    __syncthreads();
    float mrow[4][4], srow[4][4];
#pragma unroll
    for (int rt = 0; rt < 4; ++rt)
#pragma unroll
        for (int j = 0; j < 4; ++j) { const int row = 16 * rt + 4 * q + j; const f32x4 m0 = *(const LAS f32x4*)(RED + row * 8), m1 = *(const LAS f32x4*)(RED + row * 8 + 4);
            mrow[rt][j] = fmaxf(fmaxf(fmaxf(m0[0], m0[1]), fmaxf(m0[2], m0[3])), fmaxf(fmaxf(m1[0], m1[1]), fmaxf(m1[2], m1[3]))); srow[rt][j] = 0.f; }
#pragma unroll
    for (int i = 0; i < 5; ++i) { const int kt = w + 8 * i;
        if (kt < NT) {
#pragma unroll
            for (int rt = 0; rt < 4; ++rt)
#pragma unroll
                for (int j = 0; j < 4; ++j) { const float pv = __expf(sc[i][rt][j] - mrow[rt][j]); srow[rt][j] += pv; PL[(16 * rt + 4 * q + j) * 600 + 16 * kt + r] = f2bf(pv); } } }
#pragma unroll
    for (int rt = 0; rt < 4; ++rt)
#pragma unroll
        for (int j = 0; j < 4; ++j) { float sv = srow[rt][j];
#pragma unroll
            for (int o = 1; o < 16; o <<= 1) sv += __shfl_xor(sv, o);
            if (r == 0) LS[(16 * rt + 4 * q + j) * 8 + w] = sv; }
    __syncthreads();
    f32x4 o[4];
#pragma unroll
    for (int rt = 0; rt < 4; ++rt) o[rt] = (f32x4){0.f, 0.f, 0.f, 0.f};
    const int d = 16 * w + r;
    const int nks = NT / 2;
#pragma unroll
    for (int g = 0; g < 3; ++g) {
        if (6 * g < nks) {
            bf16x8 vb[6];
#pragma unroll
            for (int e = 0; e < 6; ++e) { const int ks = min(6 * g + e, nks - 1);
                if (!smp) vb[e] = *(const bf16x8*)(vat + ((size_t)((b * 8 + h) * 128 + d)) * 2048 + tk0 + 32 * ks + 8 * q);
                else { const int key0 = 32 * ks + 8 * q; const float* vp = key0 < 512 ? p.cache_v + ((size_t)(b * 512 + key0) * 8 + h) * 128 + d : vsn + ((size_t)(b * 32 + key0 - 512) * 8 + h) * 128 + d;
                    f32x4 x0, x1;
#pragma unroll
                    for (int e2 = 0; e2 < 4; ++e2) { x0[e2] = vp[(size_t)e2 * 1024]; x1[e2] = vp[(size_t)(e2 + 4) * 1024]; }
                    vb[e] = as_bf8(pack8(x0, x1)); } }
#pragma unroll
            for (int e = 0; e < 6; ++e) { const int ks = 6 * g + e;
                if (ks < nks) {
#pragma unroll
                    for (int rt = 0; rt < 4; ++rt) { const bf16x8 a = *(const LAS bf16x8*)(PL + (16 * rt + r) * 600 + 32 * ks + 8 * q); o[rt] = mfma16(a, vb[e], o[rt]); } } } } }
#pragma unroll
    for (int rt = 0; rt < 4; ++rt)
#pragma unroll
        for (int j = 0; j < 4; ++j) { const int row = 16 * rt + 4 * q + j; const f32x4 l0 = *(const LAS f32x4*)(LS + row * 8), l1 = *(const LAS f32x4*)(LS + row * 8 + 4);
            const float inv = __builtin_amdgcn_rcpf(((l0[0] + l0[1]) + (l0[2] + l0[3])) + ((l1[0] + l1[1]) + (l1[2] + l1[3])));
            if (!smp || row < 32) oa[(size_t)(rq0 + row) * 3072 + h * 128 + d] = f2bf(o[rt][j] * inv); }
    __syncthreads();
}

__device__ __forceinline__ void phase_normgate(const Params& p) {
    const int lane = threadIdx.x & 63, gw = blockIdx.x * 8 + (threadIdx.x >> 6), NGW = gridDim.x * 8;
    u16* og = (u16*)p.out + 1024; const u16* rgb = (const u16*)(p.ws + R_RG);
    for (int it = gw; it < M * 4; it += NGW) { const int row = it >> 2, h = it & 3; const size_t o = (size_t)row * 3072 + h * 512 + 8 * lane, orr = (size_t)row * 2048 + h * 512 + 8 * lane;
        const u32x4 ov = *(const u32x4*)(og + o), rv = *(const u32x4*)(rgb + orr);
        float v[8] = {bf_lo(ov.x), bf_hi(ov.x), bf_lo(ov.y), bf_hi(ov.y), bf_lo(ov.z), bf_hi(ov.z), bf_lo(ov.w), bf_hi(ov.w)};
        float rr[8] = {bf_lo(rv.x), bf_hi(rv.x), bf_lo(rv.y), bf_hi(rv.y), bf_lo(rv.z), bf_hi(rv.z), bf_lo(rv.w), bf_hi(rv.w)};
        float ss = 0.f;
#pragma unroll
        for (int e = 0; e < 8; ++e) ss += v[e] * v[e];
        const float rstd = rsqrtf(wave_sum(ss) * (1.f / 512.f) + 1e-6f);
        const f32x4 g0 = *(const f32x4*)(p.norm_g + h * 512 + 8 * lane), g1 = *(const f32x4*)(p.norm_g + h * 512 + 8 * lane + 4);
        float res[8];
#pragma unroll
        for (int e = 0; e < 8; ++e) { const float g = e < 4 ? g0[e] : g1[e - 4]; res[e] = v[e] * rstd * g * (rr[e] * __builtin_amdgcn_rcpf(1.f + __expf(-rr[e]))); }
        u32x4 w; w.x = cvt_pk_bf16(res[0], res[1]); w.y = cvt_pk_bf16(res[2], res[3]); w.z = cvt_pk_bf16(res[4], res[5]); w.w = cvt_pk_bf16(res[6], res[7]);
        *(u32x4*)(og + o) = w; }
}
template <bool TO_BF16, bool SRC_BF16>
__device__ __forceinline__ void phase_ln(const float* src, const u16* srcb, const float* g, const float* bta, u16* dstb, float* dstf) {
    const int lane = threadIdx.x & 63, gw = blockIdx.x * 8 + (threadIdx.x >> 6), NGW = gridDim.x * 8;
    for (int row = gw; row < M; row += NGW) { const float* s = src + (size_t)row * 2048;
        f32x4 v[8]; float sum = 0.f;
#pragma unroll
        for (int j = 0; j < 8; ++j) { if (SRC_BF16) { const u32x2 wv = *(const u32x2*)(srcb + (size_t)row * 2048 + (j * 64 + lane) * 4); v[j] = (f32x4){bf_lo(wv.x), bf_hi(wv.x), bf_lo(wv.y), bf_hi(wv.y)}; } else v[j] = *(const f32x4*)(s + (j * 64 + lane) * 4);
            sum += (v[j][0] + v[j][1]) + (v[j][2] + v[j][3]); }
        const float mean = wave_sum(sum) * (1.f / 2048.f); float s2 = 0.f;
#pragma unroll
        for (int j = 0; j < 8; ++j) { v[j] = v[j] - mean; s2 += (v[j][0] * v[j][0] + v[j][1] * v[j][1]) + (v[j][2] * v[j][2] + v[j][3] * v[j][3]); }
        const float rstd = rsqrtf(wave_sum(s2) * (1.f / 2048.f) + 1e-5f);
#pragma unroll
        for (int j = 0; j < 8; ++j) { const int c = (j * 64 + lane) * 4; const f32x4 gg = *(const f32x4*)(g + c), bb = *(const f32x4*)(bta + c); const f32x4 y = v[j] * rstd * gg + bb;
            if (TO_BF16) { u32x2 w; w.x = cvt_pk_bf16(y[0], y[1]); w.y = cvt_pk_bf16(y[2], y[3]); *(u32x2*)(dstb + (size_t)row * 2048 + c) = w; }
            else *(f32x4*)(dstf + (size_t)row * 2048 + c) = y; } }
}

template <class Epi>
__device__ __forceinline__ void run_gemm(LAS unsigned char* lds, const u16* A, const u16* Bt, int N, int K, const Epi& E) {
    pg8::Gemm g; g.A = A; g.Bt = Bt; g.M = M; g.N = N; g.K = K;
    pg8::StaticOrder S; S.init(M, N, (int)gridDim.x, (int)blockIdx.x);
    pg8::gemm_phase<Epi, pg8::StaticOrder, false>(lds, g, S, E, nullptr);
}

__device__ __forceinline__ void gsync(cg::grid_group& g) { asm volatile("s_waitcnt vmcnt(0) lgkmcnt(0)" ::: "memory"); g.sync(); asm volatile("" ::: "memory"); }

__global__ __launch_bounds__(512, 2) void fwd_megakernel(Params p) {
    extern __shared__ __attribute__((aligned(16))) unsigned char shm[];
    LAS unsigned char* lds = (LAS unsigned char*)shm;
    cg::grid_group grid = cg::this_grid();
    unsigned char* ws = p.ws;
    phase0(lds, p);
#ifdef PROBE_P02
    phase0(lds, p);
#endif
    gsync(grid);
#if defined(STOP_AFTER) && STOP_AFTER == 1
    return;
#endif
#ifndef SKIP_Z
    { EpiZ E; E.ws = ws; E.out = p.out; E.merge_b = p.merge_b; run_gemm(lds, (const u16*)p.out, (const u16*)(ws + W_IN), ZN, 2048, E);
      { const int nunits = (M / 256) * (ZN / 256), full = nunits % (int)gridDim.x;
        if (full == 0) phase0_rest(lds, p, (int)blockIdx.x, (int)gridDim.x);
        else if ((int)blockIdx.x >= full) phase0_rest(lds, p, (int)blockIdx.x - full, (int)gridDim.x - full); }
#ifdef PROBE_Z2
      run_gemm(lds, (const u16*)p.out, (const u16*)(ws + W_IN), ZN, 2048, E);
#endif
    }
#endif
    gsync(grid);
#if defined(STOP_AFTER) && STOP_AFTER == 2
    return;
#endif
    { float gu0[16], gu1[16], gb0 = 0.f, gb1 = 0.f; int hcur = -1;
      for (int pu = blockIdx.x; pu < 2176; pu += gridDim.x) gla_prep_unit(lds, p, pu, gu0, gu1, gb0, gb1, hcur); }
    { int hprev = -1;
      if (gridDim.x == 256) {
          for (int rd = 0; rd < 16; ++rd) attn_unit<false>(lds, p, ((rd * 8 + ((int)blockIdx.x & 7)) << 5) + ((((int)blockIdx.x >> 3) + 5 * rd) & 31), hprev);
      } else { for (int u = blockIdx.x; u < 4096; u += gridDim.x) attn_unit<false>(lds, p, u, hprev); }
      for (int u = 4096 + blockIdx.x; u < 4352; u += gridDim.x) attn_unit<true>(lds, p, u, hprev); }
    gsync(grid);
    for (int u = blockIdx.x; u < 768; u += gridDim.x) gla_unit(lds, p, u);
#ifdef PROBE_GLA2
    for (int u = blockIdx.x; u < 768; u += gridDim.x) gla_unit(lds, p, u);
#endif
    gsync(grid);
    phase_normgate(p);
    gsync(grid);
#if defined(STOP_AFTER) && STOP_AFTER == 4
    return;
#endif
    { EpiBr E; E.ga = (const u16*)(ws + R_MG); E.gb = (const u16*)(ws + R_MA); E.t = (u16*)(ws + R_T); run_gemm(lds, (const u16*)p.out, (const u16*)(ws + W_BRG), 2048, 3072, E); }
    gsync(grid);
#if defined(STOP_AFTER) && STOP_AFTER == 6
    return;
#endif
    { EpiOut E; E.xp = p.x_prompt; E.xs = p.x_sample; E.dst = (u16*)(ws + R_VG); run_gemm(lds, (const u16*)(ws + R_T), (const u16*)(ws + W_OUT), 2048, 2048, E); }
    gsync(grid);
#if defined(STOP_AFTER) && STOP_AFTER == 7
    return;
#endif
    phase_ln<true, true>(nullptr, (const u16*)(ws + R_VG), p.ln1_g, p.ln1_b, (u16*)(ws + R_HB), nullptr);
    gsync(grid);
#if defined(STOP_AFTER) && STOP_AFTER == 8
    return;
#endif
#ifndef SKIP_UP
    { EpiUp E; E.conv_w = p.conv_w; E.conv_b = p.conv_b; E.state_conv = p.state_conv; E.out = p.out; E.a = (u16*)(ws + R_AACT);
      E.uh = (float*)(ws + R_SIDE); E.uf = E.uh + SZ_SIDE / 4; E.gf = E.uf + SZ_SIDE / 4; run_gemm(lds, (const u16*)(ws + R_HB), (const u16*)(ws + W_UP), NUP, 2048, E);
      { const int nunits = (M / 256) * (NUP / 256), full = nunits % (int)gridDim.x;
        if (full == 0) phase0_dn(lds, p, (int)blockIdx.x, (int)gridDim.x);
        else if ((int)blockIdx.x >= full) phase0_dn(lds, p, (int)blockIdx.x - full, (int)gridDim.x - full); }
#ifdef PROBE_UP2
      run_gemm(lds, (const u16*)(ws + R_HB), (const u16*)(ws + W_UP), NUP, 2048, E);
#endif
    }
#endif
    gsync(grid);
#if defined(STOP_AFTER) && STOP_AFTER == 9
    return;
#endif
    phase_fixup(p);
    gsync(grid);
#if defined(STOP_AFTER) && STOP_AFTER == 10
    return;
#endif
    { EpiDown E; E.hb = (const u16*)(ws + R_HB); E.dst = (u16*)(ws + R_VG); run_gemm(lds, (const u16*)(ws + R_AACT), (const u16*)(ws + W_DN), 2048, DFF, E); }
    gsync(grid);
#if defined(STOP_AFTER) && STOP_AFTER == 11
    return;
#endif
    phase_ln<false, true>(nullptr, (const u16*)(ws + R_VG), p.ln2_g, p.ln2_b, nullptr, p.out);
}

extern "C" void kernel_launch(void* const* d_in, const int* in_sizes, int n_in, void* d_out, int out_size, void* d_ws, size_t ws_size, hipStream_t stream) {
    static int grid_blocks = 0;
    if (!grid_blocks) {
        if (n_in != 23 || ws_size < WS_END) { fprintf(stderr, "kernel_launch: need 23 inputs and >= %zu bytes of workspace (got %d, %zu)\n", (size_t)WS_END, n_in, ws_size); grid_blocks = -1; return; }
        int dev = 0, cus = 0, per_cu = 0;
        hipGetDevice(&dev);
        hipDeviceGetAttribute(&cus, hipDeviceAttributeMultiprocessorCount, dev);
        if (hipFuncSetAttribute((const void*)fwd_megakernel, hipFuncAttributeMaxDynamicSharedMemorySize, LDS_BYTES) != hipSuccess) { fprintf(stderr, "kernel_launch: hipFuncSetAttribute failed\n"); grid_blocks = -1; return; }
        hipOccupancyMaxActiveBlocksPerMultiprocessor(&per_cu, (const void*)fwd_megakernel, 512, LDS_BYTES);
        if (per_cu < 1) { fprintf(stderr, "kernel_launch: occupancy query says %d blocks per CU\n", per_cu); per_cu = 1; }
        (void)hipGetLastError();
        grid_blocks = cus * per_cu;
    }
    if (grid_blocks < 0) return;
    Params p{};
    const float** f = (const float**)&p;
    for (int i = 0; i < 23; ++i) f[i] = (const float*)d_in[i];
    p.out = (float*)d_out; p.ws = (unsigned char*)d_ws;
    void* args[] = {&p};
    hipError_t e = hipLaunchCooperativeKernel((const void*)fwd_megakernel, dim3(grid_blocks), dim3(512), args, LDS_BYTES, stream);
    if (e != hipSuccess) fprintf(stderr, "cooperative launch failed: %s (grid %d)\n", hipGetErrorString(e), grid_blocks);
}
```

```cpp
#include <hip/hip_runtime.h>
#include <hip/hip_cooperative_groups.h>
#include <cstdio>
namespace cg = cooperative_groups;
namespace pg8 {
#define PG8_LAS __attribute__((address_space(3)))
typedef unsigned short bf16_t;
typedef short bf16x8 __attribute__((ext_vector_type(8)));
typedef float f32x4 __attribute__((ext_vector_type(4)));
typedef unsigned u32x4 __attribute__((ext_vector_type(4)));
constexpr int BM = 256, BK = 64, HALF = 128, HTB = HALF * BK * 2  , STAGE_BYTES = 8 * HTB, NXCD = 8, WGM = 4;

__host__ __device__ __forceinline__ int lds_byte(int r, int c) { const int st = (r >> 4) * 2 + (c >> 5), rr = r & 15, cc = c & 31, ob = rr * 64 + cc * 2; return st * 1024 + (ob ^ (((ob >> 9) & 1) << 5)); }
__host__ __device__ __forceinline__ void stage_rc(int b, int& R, int& C) { const int st = b / 1024, sb = b % 1024, swz = sb ^ (((sb >> 9) & 1) << 5); R = (st >> 1) * 16 + swz / 64; C = (st & 1) * 32 + (swz % 64) / 2; }
__host__ __device__ __forceinline__ int perm32(int rho) { const int n = rho >> 4, i = rho & 15; return 8 * (i >> 2) + 4 * n + (i & 3); }

struct Unit { int pm, pn; };
struct Gemm { const bf16_t* A; const bf16_t* Bt; int M, N, K; };

struct StaticOrder {
    int nM, nN, nwg, G, c;
    __host__ __device__ void init(int M, int N, int G_, int c_) { nM = M / BM; nN = N / BM; nwg = nM * nN; G = G_; c = c_; }
    __host__ __device__ bool next(int i, Unit& u) const {
        const long L = (long)i * G + c; if (L >= nwg) return false;
        int wgid = (int)L; { const int q = nwg / NXCD, r = nwg % NXCD, xcd = wgid % NXCD, off = wgid / NXCD; wgid = (xcd < r ? xcd * (q + 1) : r * (q + 1) + (xcd - r) * q) + off; }
        const int nig = WGM * nN, gid = wgid / nig, fm = gid * WGM, gsz = (nM - fm) < WGM ? (nM - fm) : WGM;
        u.pm = fm + ((wgid % nig) % gsz); u.pn = (wgid % nig) / gsz; return true;
    }
    __device__ __forceinline__ void a_ready(const Unit&) const {}
    __device__ __forceinline__ void done(const Unit&) const {}
};
typedef float f32x2_c __attribute__((ext_vector_type(2))); typedef __bf16 bf16x2_c __attribute__((ext_vector_type(2)));
__device__ __forceinline__ unsigned cvt_pk_bf16(float lo, float hi) { const f32x2_c v = {lo, hi}; return __builtin_bit_cast(unsigned, __builtin_convertvector(v, bf16x2_c)); }
template <class Epi, class Sched, bool STAMP = false>
__device__ __forceinline__ void gemm_phase(PG8_LAS unsigned char* lds, const Gemm g, const Sched& S, const Epi& E, unsigned long long* stamps) {
    int tid = threadIdx.x; asm volatile("" : "+v"(tid)); const int wid = __builtin_amdgcn_readfirstlane(tid >> 6), lane = tid & 63, wr = wid >> 2, wc = wid & 3, fr = lane & 15, fq = lane >> 4;
    const int K = g.K, nt = K / BK;
    int ts_lo = 0, ts_hi = 0, nts = 0; const unsigned long long rt_entry = STAMP ? (unsigned long long)wall_clock64() : 0ull;
#define PG8_STAMP() do { if (STAMP && wid == 0 && nts < 64) { const unsigned long long _c = (unsigned long long)clock64(); \
        ts_lo = (lane == nts) ? (int)(unsigned)_c : ts_lo; ts_hi = (lane == nts) ? (int)(unsigned)(_c >> 32) : ts_hi; ++nts; } } while (0)
    PG8_STAMP();
    unsigned voffA[2], voffB[2];
#pragma unroll
    for (int i = 0; i < 2; ++i) { int R, C; stage_rc(tid * 16 + i * 8192, R, C); const int Rb = Epi::PERM ? ((R & ~31) + perm32(R & 31)) : R;
        voffA[i] = (unsigned)(R * K + C) * 2u; voffB[i] = (unsigned)(Rb * K + C) * 2u; }
    const size_t kstep = (size_t)(BK * 2);
    const size_t hstep = (size_t)HALF * K * 2;
    const size_t tstep = 2 * hstep;
    const unsigned ldsw = (unsigned)wid * 1024u;
    const int aoff = lds_byte(wr * 64 + fr, fq * 8), boff = lds_byte(wc * 32 + fr, fq * 8);
#define PG8_SA(b, h) (((b) * 2 + (h)) * HTB)
#define PG8_SB(b, h) ((4 + (b) * 2 + (h)) * HTB)
#define PG8_STAGE(bufoff, gbase, voff) do { _Pragma("unroll") for (int _i = 0; _i < 2; ++_i) \
        __builtin_amdgcn_global_load_lds((const unsigned*)((const char*)(gbase) + (voff)[_i]), (PG8_LAS unsigned*)(lds + (bufoff) + ldsw + _i * 8192), 16, 0, 0); } while (0)
#define PG8_LDA(dst, b, h) do { _Pragma("unroll") for (int m = 0; m < 4; ++m) _Pragma("unroll") for (int k = 0; k < 2; ++k) dst[m][k] = *(const PG8_LAS bf16x8*)(lds + PG8_SA(b, h) + aoff + m * 2048 + k * 1024); } while (0)
#define PG8_LDB(dst, b, h) do { _Pragma("unroll") for (int n = 0; n < 2; ++n) _Pragma("unroll") for (int k = 0; k < 2; ++k) dst[n][k] = *(const PG8_LAS bf16x8*)(lds + PG8_SB(b, h) + boff + n * 2048 + k * 1024); } while (0)
#define PG8_MMA(ai, bj, At, Bt) do { __builtin_amdgcn_s_setprio(1); _Pragma("unroll") for (int m = 0; m < 4; ++m) _Pragma("unroll") for (int n = 0; n < 2; ++n) _Pragma("unroll") for (int k = 0; k < 2; ++k) \
        acc[ai][bj][m][n] = __builtin_amdgcn_mfma_f32_16x16x32_bf16(Bt[n][k], At[m][k], acc[ai][bj][m][n], 0, 0, 0); __builtin_amdgcn_s_setprio(0); } while (0)
#define PG8_WAIT_V(n) asm volatile("s_waitcnt vmcnt(" #n ")" ::: "memory")
#define PG8_WAIT_L(n) asm volatile("s_waitcnt lgkmcnt(" #n ")" ::: "memory")
#define PG8_BAR __builtin_amdgcn_s_barrier()
#define PG8_SCHED __builtin_amdgcn_sched_barrier(0)
    Unit cur, nxt; int ui = 0;
    if (!S.next(0, cur)) return;
    f32x4 acc[2][2][4][2];
#pragma unroll
    for (int a = 0; a < 2; ++a)
#pragma unroll
        for (int b = 0; b < 2; ++b)
#pragma unroll
            for (int m = 0; m < 4; ++m)
#pragma unroll
                for (int n = 0; n < 2; ++n) acc[a][b][m][n] = (f32x4){0.f, 0.f, 0.f, 0.f};
    bf16x8 At[4][2], B0[2][2], B1[2][2];
    const char* cA = (const char*)g.A + (size_t)cur.pm * tstep; const char* cB = (const char*)g.Bt + (size_t)cur.pn * tstep;
    S.a_ready(cur);
    PG8_STAGE(PG8_SB(0, 0), cB, voffB); PG8_STAGE(PG8_SA(0, 0), cA, voffA); PG8_STAGE(PG8_SB(0, 1), cB + hstep, voffB); PG8_STAGE(PG8_SA(0, 1), cA + hstep, voffA);
    if (wr == 1) PG8_BAR;
    PG8_WAIT_V(4); PG8_BAR;
    PG8_STAGE(PG8_SB(1, 0), cB + kstep, voffB); PG8_STAGE(PG8_SA(1, 0), cA + kstep, voffA); PG8_STAGE(PG8_SB(1, 1), cB + hstep + kstep, voffB);
    PG8_WAIT_V(6); PG8_BAR;
    PG8_STAMP();
    for (;;) {
        const bool has_next = S.next(ui + 1, nxt);
        const char* nA = has_next ? (const char*)g.A + (size_t)nxt.pm * tstep : cA; const char* nB = has_next ? (const char*)g.Bt + (size_t)nxt.pn * tstep : cB;
        int t = 0;
        for (int seg = 0; seg < (Epi::HOOK_T >= 0 ? 2 : 1); ++seg) {
        const int tend = (Epi::HOOK_T >= 0 && seg == 0) ? Epi::HOOK_T : nt;
        for (; t < tend; t += 2) {
            const bool last = (t == nt - 2);
            const char* a1 = cA + (size_t)(t + 1) * kstep;
            const char* a2 = last ? nA : cA + (size_t)(t + 2) * kstep; const char* b2 = last ? nB : cB + (size_t)(t + 2) * kstep;
            const char* a3 = a2 + kstep; const char* b3 = b2 + kstep;
            if (last && has_next) S.a_ready(nxt);
            PG8_LDB(B0, 0, 0); PG8_SCHED; PG8_LDA(At, 0, 0); PG8_STAGE(PG8_SA(1, 1), a1 + hstep, voffA);
            PG8_WAIT_L(8); PG8_BAR; PG8_WAIT_L(0); PG8_MMA(0, 0, At, B0); PG8_BAR; PG8_SCHED;
            PG8_LDB(B1, 0, 1); PG8_STAGE(PG8_SB(0, 0), b2, voffB);
            PG8_BAR; PG8_WAIT_L(0); PG8_MMA(0, 1, At, B1); PG8_BAR;
            PG8_LDA(At, 0, 1); PG8_STAGE(PG8_SA(0, 0), a2, voffA);
            PG8_BAR; PG8_WAIT_L(0); PG8_MMA(1, 0, At, B0); PG8_BAR; PG8_SCHED;
            PG8_STAGE(PG8_SB(0, 1), b2 + hstep, voffB);
            PG8_WAIT_V(6); PG8_BAR; PG8_MMA(1, 1, At, B1); PG8_BAR;
            PG8_LDB(B0, 1, 0); PG8_SCHED; PG8_LDA(At, 1, 0); PG8_STAGE(PG8_SA(0, 1), a2 + hstep, voffA);
            PG8_WAIT_L(8); PG8_BAR; PG8_WAIT_L(0); PG8_MMA(0, 0, At, B0); PG8_BAR; PG8_SCHED;
            PG8_LDB(B1, 1, 1); PG8_STAGE(PG8_SB(1, 0), b3, voffB);
            PG8_BAR; PG8_WAIT_L(0); PG8_MMA(0, 1, At, B1); PG8_BAR;
            PG8_LDA(At, 1, 1); PG8_STAGE(PG8_SA(1, 0), a3, voffA);
            PG8_BAR; PG8_WAIT_L(0); PG8_MMA(1, 0, At, B0); PG8_BAR; PG8_SCHED;
            PG8_STAGE(PG8_SB(1, 1), b3 + hstep, voffB);
            PG8_WAIT_V(6); PG8_BAR; PG8_MMA(1, 1, At, B1); PG8_BAR;
        }
        if constexpr (Epi::HOOK_T >= 0) { if (seg == 0) E.hook(acc, cur, wr, wc, fr, fq); }
        }
        PG8_STAMP();
        if constexpr (!Epi::AFTER_DRAIN) { E(acc, cur, wr, wc, fr, fq); S.done(cur); }
        PG8_STAMP();
        if (!has_next) break;
#pragma unroll
        for (int a = 0; a < 2; ++a)
#pragma unroll
            for (int b = 0; b < 2; ++b)
#pragma unroll
                for (int m = 0; m < 4; ++m)
#pragma unroll
                    for (int n = 0; n < 2; ++n) acc[a][b][m][n] = (f32x4){0.f, 0.f, 0.f, 0.f};
        cur = nxt; cA = nA; cB = nB; ++ui;
    }
    PG8_WAIT_V(0);
    if (wr == 0) PG8_BAR;
    PG8_BAR;
    if constexpr (Epi::AFTER_DRAIN) { E.fused(acc, cur, wr, wc, fr, fq, lds, wid, lane); S.done(cur); }
    PG8_STAMP();
    if (STAMP && wid == 0) { stamps[lane] = lane < nts ? (((unsigned long long)(unsigned)ts_hi << 32) | (unsigned)ts_lo) : 0ull;
        if (lane == 62) stamps[62] = rt_entry; if (lane == 63) stamps[63] = (unsigned long long)wall_clock64(); }
#undef PG8_STAMP
#undef PG8_SA
#undef PG8_SB
#undef PG8_STAGE
#undef PG8_LDA
#undef PG8_LDB
#undef PG8_MMA
#undef PG8_WAIT_V
#undef PG8_WAIT_L
#undef PG8_BAR
#undef PG8_SCHED
}
}

#define LAS PG8_LAS
using pg8::bf16x8; using pg8::f32x4; using pg8::u32x4; using pg8::Unit; using pg8::cvt_pk_bf16;
typedef unsigned short u16;
typedef unsigned u32x2 __attribute__((ext_vector_type(2)));

constexpr int M = 33792, MP = 32768, DM = 2048, DFF = 5504, ZN = 13568, NUP = 11008;
constexpr int LDS_BYTES = 147456;
constexpr float DN_ALPHA = 1.189207115002721f;
constexpr size_t O_Y = 0, O_KP = 69206016, O_VP = 77594624, O_SP = 85983232, O_CP = 94371840, O_KS = 94547968, O_VS = 95596544, O_SS = 96645120, O_CS = 113422336;
constexpr size_t SZ_R1 = (size_t)M * 1024 * 2, SZ_R2 = (size_t)M * 2048 * 2;
constexpr size_t W_IN = 0, W_BRG = W_IN + (size_t)ZN * 2048 * 2, W_BRA = W_BRG + (size_t)2048 * 2048 * 2, W_OUT = W_BRA + (size_t)2048 * 1024 * 2,
                 W_UP = W_OUT + (size_t)2048 * 2048 * 2, W_DN = W_UP + (size_t)NUP * 2048 * 2, W_END = W_DN + (size_t)2048 * DFF * 2;
constexpr size_t R_QG = W_END, R_KG = R_QG + SZ_R1, R_VG = R_KG + SZ_R1, R_RG = R_VG + SZ_R2, R_QA = R_RG + SZ_R2, R_KA = R_QA + SZ_R1, R_VAT = R_KA + SZ_R1,
                 R_MG = R_VAT + (size_t)16 * 8 * 128 * 2048 * 2, R_MA = R_MG + SZ_R2, R_ALO = R_MA + SZ_R2, R_DEC = R_ALO + (size_t)M * 16 * 4, WS_END = R_DEC + (size_t)544 * 1024 * 4;
constexpr size_t R_T1 = R_QG, R_T = R_RG, R_HB = R_QG, R_SIDE = R_VG, R_AACT = R_RG;
constexpr int NSEG = M / 64;
constexpr size_t SZ_SIDE = (size_t)NSEG * 2 * DFF * 4;

struct Params {
    const float *x_prompt, *x_sample, *cache_k, *cache_v, *state_gla, *state_conv, *w_in, *gate_up, *gate_b, *norm_g, *rel_bias, *merge_b, *w_brg, *w_bra, *w_out,
        *ln1_g, *ln1_b, *w_up, *conv_w, *conv_b, *w_dn, *ln2_g, *ln2_b;
    float* out; unsigned char* ws;
};

__device__ __forceinline__ int opaque_tid() { int t = threadIdx.x; asm volatile("" : "+v"(t)); return t; }
__device__ __forceinline__ float bf_lo(unsigned w) { return __uint_as_float(w << 16); }
__device__ __forceinline__ float bf_hi(unsigned w) { return __uint_as_float(w & 0xffff0000u); }
__device__ __forceinline__ bf16x8 as_bf8(u32x4 v) { return __builtin_bit_cast(bf16x8, v); }
__device__ __forceinline__ f32x4 mfma16(bf16x8 a, bf16x8 b, f32x4 c) { return __builtin_amdgcn_mfma_f32_16x16x32_bf16(a, b, c, 0, 0, 0); }
__device__ __forceinline__ u16 f2bf(float f) { return (u16)(cvt_pk_bf16(f, 0.f) & 0xffffu); }
__device__ __forceinline__ float sigmoidf_(float x) { return __builtin_amdgcn_rcpf(1.f + __expf(-x)); }
__device__ __forceinline__ float gelu_tanh(float x) { const float t = 1.5957691216057308f * (x + 0.044715f * x * x * x); return x * __builtin_amdgcn_rcpf(1.f + __expf(-t)); }
__device__ __forceinline__ float wave_sum(float v) {
#pragma unroll
    for (int o = 1; o < 64; o <<= 1) v += __shfl_xor(v, o);
    return v;
}
__device__ __forceinline__ u32x4 pack8(f32x4 a, f32x4 b) { u32x4 w; w.x = cvt_pk_bf16(a[0], a[1]); w.y = cvt_pk_bf16(a[2], a[3]); w.z = cvt_pk_bf16(b[0], b[1]); w.w = cvt_pk_bf16(b[2], b[3]); return w; }

template <class Map>
__device__ __forceinline__ void transpose_mat(const float* W, int K, int Nsrc, u16* WT, int Ndst, Map map, LAS float* scr, int gw, int NGW, int lane, int ldd = 0, int coff = 0) {
    if (ldd == 0) ldd = K;
    const int nblk = Ndst / 32, nitems = (K / 64) * nblk;
    const int c4 = lane & 7, kr = lane >> 3;
    f32x4 v[8];
#define TM_LOAD(itx) do { const int kb_ = (itx) / nblk, nb_ = (itx) % nblk; const int sc_ = map(32 * nb_ + 4 * c4); const float* wp_ = W + (size_t)(64 * kb_ + kr) * Nsrc + (sc_ >= 0 ? sc_ : 0); \
        _Pragma("unroll") for (int i = 0; i < 8; ++i) v[i] = sc_ >= 0 ? *(const f32x4*)(wp_ + (size_t)(8 * i) * Nsrc) : (f32x4){0.f, 0.f, 0.f, 0.f}; } while (0)
    int it = gw;
    if (it < nitems) TM_LOAD(it);
    for (; it < nitems; it += NGW) {
        const int kb = it / nblk, nb = it % nblk, k0 = 64 * kb, n0 = 32 * nb;
#pragma unroll
        for (int i = 0; i < 8; ++i)
#pragma unroll
            for (int e = 0; e < 4; ++e) scr[(kr + 8 * i) * 33 + 4 * c4 + e] = v[i][e];
        if (it + NGW < nitems) TM_LOAD(it + NGW);
        __builtin_amdgcn_wave_barrier();
        const int c = lane & 7;
#pragma unroll
        for (int j = 0; j < 4; ++j) { const int n = (lane >> 3) + 8 * j; const LAS float* s = scr + (8 * c) * 33 + n;
            u32x4 o; o.x = cvt_pk_bf16(s[0 * 33], s[1 * 33]); o.y = cvt_pk_bf16(s[2 * 33], s[3 * 33]); o.z = cvt_pk_bf16(s[4 * 33], s[5 * 33]); o.w = cvt_pk_bf16(s[6 * 33], s[7 * 33]);
            *(u32x4*)(WT + (size_t)(n0 + n) * ldd + coff + k0 + 8 * c) = o; }
        __builtin_amdgcn_wave_barrier();
    }
#undef TM_LOAD
}
struct MapId { __device__ __forceinline__ int operator()(int n) const { return n; } };
struct MapIn { __device__ __forceinline__ int operator()(int n) const { return n < 6144 ? n : (n < 13312 ? n + 16 : (n < 13328 ? n - 13312 + 6144 : -1)); } };
struct MapUp { __device__ __forceinline__ int operator()(int n) const { const int pn = n >> 8, j = n & 255; return j < 128 ? 128 * pn + j : DFF + 128 * pn + (j - 128); } };

__device__ __forceinline__ void phase0(LAS unsigned char* lds, const Params& p) {
    const int tid = opaque_tid(), lane = tid & 63, w = tid >> 6;
    const int gw = blockIdx.x * 8 + w, NGW = gridDim.x * 8;
    LAS float* scr = (LAS float*)(lds + w * 8704);
    transpose_mat(p.w_in, 2048, 13328, (u16*)(p.ws + W_IN), ZN, MapIn(), scr, gw, NGW, lane);
    u16* xb = (u16*)p.out;
    const size_t n8 = (size_t)M * DM / 8, np8 = (size_t)MP * DM / 8;
    for (size_t i = (size_t)blockIdx.x * 512 + tid; i < n8; i += (size_t)gridDim.x * 512) {
        const float* s = i < np8 ? p.x_prompt + i * 8 : p.x_sample + (i - np8) * 8;
        const f32x4 a = *(const f32x4*)s, b = *(const f32x4*)(s + 4);
        *(u32x4*)(xb + i * 8) = pack8(a, b);
    }
}

__device__ __forceinline__ void phase0_rest(LAS unsigned char* lds, const Params& p, int widx, int nw) {
    const int tid = opaque_tid(), lane = tid & 63, w = tid >> 6;
    const int gw = widx * 8 + w, NGW = nw * 8;
    LAS float* scr = (LAS float*)(lds + w * 8704);
    transpose_mat(p.w_brg, 2048, 2048, (u16*)(p.ws + W_BRG), 2048, MapId(), scr, gw, NGW, lane, 3072, 1024);
    transpose_mat(p.w_bra, 1024, 2048, (u16*)(p.ws + W_BRG), 2048, MapId(), scr, gw, NGW, lane, 3072, 0);
    transpose_mat(p.w_out, 2048, 2048, (u16*)(p.ws + W_OUT), 2048, MapId(), scr, gw, NGW, lane);
    transpose_mat(p.w_up, 2048, NUP, (u16*)(p.ws + W_UP), NUP, MapUp(), scr, gw, NGW, lane);
}
__device__ __forceinline__ void phase0_dn(LAS unsigned char* lds, const Params& p, int widx, int nw) {
    const int tid = opaque_tid(), lane = tid & 63, w = tid >> 6;
    LAS float* scr = (LAS float*)(lds + w * 8704);
    transpose_mat(p.w_dn, DFF, 2048, (u16*)(p.ws + W_DN), 2048, MapId(), scr, widx * 8 + w, nw * 8, lane);
}

struct EpiZ {
    static constexpr bool PERM = true, AFTER_DRAIN = false; static constexpr int HOOK_T = -1;
    unsigned char* ws; float* out; const float* merge_b;
    __device__ __forceinline__ void operator()(const f32x4 (&acc)[2][2][4][2], const Unit& u, int wr, int wc, int fr, int fq) const {
        const int pn = u.pn, row0 = u.pm * 256 + wr * 64 + fr, colt = wc * 32 + 8 * fq;
        if (pn < 28 || (pn >= 36 && pn < 52)) {
            u16* base; int ld, c0; const float* bias = nullptr;
            if (pn < 4) { base = (u16*)(ws + R_QG); ld = 1024; c0 = pn * 256; }
            else if (pn < 8) { base = (u16*)(ws + R_KG); ld = 1024; c0 = (pn - 4) * 256; }
            else if (pn < 16) { base = (u16*)(ws + R_VG); ld = 2048; c0 = (pn - 8) * 256; }
            else if (pn < 24) { base = (u16*)(ws + R_RG); ld = 2048; c0 = (pn - 16) * 256; }
            else if (pn < 28) { base = (u16*)(ws + R_QA); ld = 1024; c0 = (pn - 24) * 256; }
            else if (pn < 44) { base = (u16*)(ws + R_MG); ld = 2048; c0 = (pn - 36) * 256; bias = merge_b; }
            else { base = (u16*)(ws + R_MA); ld = 2048; c0 = (pn - 44) * 256; bias = merge_b + 2048; }
            f32x4 bv[2][2];
#pragma unroll
            for (int bj = 0; bj < 2; ++bj)
#pragma unroll
                for (int n = 0; n < 2; ++n) bv[bj][n] = bias ? *(const f32x4*)(bias + c0 + bj * 128 + colt + 4 * n) : (f32x4){0.f, 0.f, 0.f, 0.f};
#pragma unroll
            for (int ai = 0; ai < 2; ++ai)
#pragma unroll
                for (int m = 0; m < 4; ++m) { u16* rowp = base + (size_t)(row0 + ai * 128 + m * 16) * ld + c0 + colt;
#pragma unroll
                    for (int bj = 0; bj < 2; ++bj) { f32x4 v0 = acc[ai][bj][m][0], v1 = acc[ai][bj][m][1];
                        if (bias) {
#pragma unroll
                            for (int j = 0; j < 4; ++j) { v0[j] = sigmoidf_(v0[j] + bv[bj][0][j]); v1[j] = sigmoidf_(v1[j] + bv[bj][1][j]); } }
                        __builtin_nontemporal_store(pack8(v0, v1), (u32x4*)(rowp + bj * 128)); } }
        } else if (pn < 36) {
            const bool isv = pn >= 32; const int c0 = (pn - (isv ? 32 : 28)) * 256;
            float* op = out + (isv ? O_VP : O_KP); float* os = out + (isv ? O_VS : O_KS);
            u16* kab = (u16*)(ws + R_KA); u16* vat = (u16*)(ws + R_VAT);
#pragma unroll
            for (int ai = 0; ai < 2; ++ai)
#pragma unroll
                for (int m = 0; m < 4; ++m) { const int row = row0 + ai * 128 + m * 16;
#pragma unroll
                    for (int bj = 0; bj < 2; ++bj) { const int c = c0 + bj * 128 + colt; const f32x4 v0 = acc[ai][bj][m][0], v1 = acc[ai][bj][m][1];
                        if (row < MP) { const int t = row & 2047, b = row >> 11;
                            if (t >= 1536) { float* d = op + ((size_t)(b * 512 + t - 1536)) * 1024 + c; *(f32x4*)d = v0; *(f32x4*)(d + 4) = v1; }
                            if (!isv) *(u32x4*)(kab + (size_t)row * 1024 + c) = pack8(v0, v1);
                            else { const int hh = c >> 7, d0 = c & 127; u16* vp = vat + ((size_t)((b * 8 + hh) * 128 + d0)) * 2048 + t;
#pragma unroll
                                for (int j = 0; j < 4; ++j) { vp[(size_t)j * 2048] = f2bf(v0[j]); vp[(size_t)(j + 4) * 2048] = f2bf(v1[j]); } }
                        } else { float* d = os + (size_t)(row - MP) * 1024 + c; *(f32x4*)d = v0; *(f32x4*)(d + 4) = v1; } } }
        } else {
            if (wc == 0 && fq < 2) { float* alo = (float*)(ws + R_ALO);
#pragma unroll
                for (int ai = 0; ai < 2; ++ai)
#pragma unroll
                    for (int m = 0; m < 4; ++m) { float* d = alo + (size_t)(row0 + ai * 128 + m * 16) * 16 + 8 * fq; *(f32x4*)d = acc[ai][0][m][0]; *(f32x4*)(d + 4) = acc[ai][0][m][1]; } }
        }
    }
};

struct EpiBr1 {
    static constexpr bool PERM = true, AFTER_DRAIN = false; static constexpr int HOOK_T = -1;
    const u16* gate; u16* t1;
    __device__ __forceinline__ void operator()(const f32x4 (&acc)[2][2][4][2], const Unit& u, int wr, int wc, int fr, int fq) const {
        const int row0 = u.pm * 256 + wr * 64 + fr, col0 = u.pn * 256 + wc * 32 + 8 * fq;
#pragma unroll
        for (int ai = 0; ai < 2; ++ai)
#pragma unroll
            for (int m = 0; m < 4; ++m) { const size_t ro = (size_t)(row0 + ai * 128 + m * 16) * 2048 + col0;
#pragma unroll
                for (int bj = 0; bj < 2; ++bj) { const u32x4 g = *(const u32x4*)(gate + ro + bj * 128); const f32x4 v0 = acc[ai][bj][m][0], v1 = acc[ai][bj][m][1];
                    const f32x4 o0 = {v0[0] * bf_lo(g.x), v0[1] * bf_hi(g.x), v0[2] * bf_lo(g.y), v0[3] * bf_hi(g.y)}, o1 = {v1[0] * bf_lo(g.z), v1[1] * bf_hi(g.z), v1[2] * bf_lo(g.w), v1[3] * bf_hi(g.w)};
                    *(u32x4*)(t1 + ro + bj * 128) = pack8(o0, o1); } }
    }
};
struct EpiBr2 {
    static constexpr bool PERM = true, AFTER_DRAIN = false; static constexpr int HOOK_T = -1;
    const u16* gate; const u16* t1; u16* t;
    __device__ __forceinline__ void operator()(const f32x4 (&acc)[2][2][4][2], const Unit& u, int wr, int wc, int fr, int fq) const {
        const int row0 = u.pm * 256 + wr * 64 + fr, col0 = u.pn * 256 + wc * 32 + 8 * fq;
#pragma unroll
        for (int ai = 0; ai < 2; ++ai)
#pragma unroll
            for (int m = 0; m < 4; ++m) { const size_t ro = (size_t)(row0 + ai * 128 + m * 16) * 2048 + col0;
#pragma unroll
                for (int bj = 0; bj < 2; ++bj) { const u32x4 g = *(const u32x4*)(gate + ro + bj * 128); const f32x4 v0 = acc[ai][bj][m][0], v1 = acc[ai][bj][m][1];
                    const u32x4 a = *(const u32x4*)(t1 + ro + bj * 128);
                    const f32x4 o0 = {bf_lo(a.x) + v0[0] * bf_lo(g.x), bf_hi(a.x) + v0[1] * bf_hi(g.x), bf_lo(a.y) + v0[2] * bf_lo(g.y), bf_hi(a.y) + v0[3] * bf_hi(g.y)};
                    const f32x4 o1 = {bf_lo(a.z) + v1[0] * bf_lo(g.z), bf_hi(a.z) + v1[1] * bf_hi(g.z), bf_lo(a.w) + v1[2] * bf_lo(g.w), bf_hi(a.w) + v1[3] * bf_hi(g.w)};
                    *(u32x4*)(t + ro + bj * 128) = pack8(o0, o1); } }
    }
};
struct EpiBr {
    static constexpr bool PERM = true, AFTER_DRAIN = false; static constexpr int HOOK_T = 16;
    const u16 *ga, *gb; u16* t;
    __device__ __forceinline__ void hook(f32x4 (&acc)[2][2][4][2], const Unit& u, int wr, int wc, int fr, int fq) const {
        unsigned base = (unsigned)(u.pm * 256 + wr * 64 + fr) * 2048u + (unsigned)(u.pn * 256 + wc * 32 + 8 * fq);
        asm volatile("" : "+v"(base));
#pragma unroll
        for (int ai = 0; ai < 2; ++ai)
#pragma unroll
            for (int m = 0; m < 4; ++m)
#pragma unroll
                for (int bj = 0; bj < 2; ++bj) { const unsigned ro = base + (unsigned)((ai * 128 + m * 16) * 2048 + bj * 128);
                    const u32x4 a = *(const u32x4*)(ga + ro), b = *(const u32x4*)(gb + ro);
                    const f32x4 r0 = {bf_lo(b.x) * __builtin_amdgcn_rcpf(bf_lo(a.x)), bf_hi(b.x) * __builtin_amdgcn_rcpf(bf_hi(a.x)), bf_lo(b.y) * __builtin_amdgcn_rcpf(bf_lo(a.y)), bf_hi(b.y) * __builtin_amdgcn_rcpf(bf_hi(a.y))};
                    const f32x4 r1 = {bf_lo(b.z) * __builtin_amdgcn_rcpf(bf_lo(a.z)), bf_hi(b.z) * __builtin_amdgcn_rcpf(bf_hi(a.z)), bf_lo(b.w) * __builtin_amdgcn_rcpf(bf_lo(a.w)), bf_hi(b.w) * __builtin_amdgcn_rcpf(bf_hi(a.w))};
                    acc[ai][bj][m][0] = acc[ai][bj][m][0] * r0; acc[ai][bj][m][1] = acc[ai][bj][m][1] * r1;
                    if (bj == 1 && m == 3) __builtin_amdgcn_sched_barrier(0); }
    }
    __device__ __forceinline__ void operator()(const f32x4 (&acc)[2][2][4][2], const Unit& u, int wr, int wc, int fr, int fq) const {
        const int row0 = u.pm * 256 + wr * 64 + fr, col0 = u.pn * 256 + wc * 32 + 8 * fq;
#pragma unroll
        for (int ai = 0; ai < 2; ++ai)
#pragma unroll
            for (int m = 0; m < 4; ++m) { const size_t ro = (size_t)(row0 + ai * 128 + m * 16) * 2048 + col0;
#pragma unroll
                for (int bj = 0; bj < 2; ++bj) { const u32x4 g = *(const u32x4*)(ga + ro + bj * 128); const f32x4 v0 = acc[ai][bj][m][0], v1 = acc[ai][bj][m][1];
                    const f32x4 o0 = {v0[0] * bf_lo(g.x), v0[1] * bf_hi(g.x), v0[2] * bf_lo(g.y), v0[3] * bf_hi(g.y)}, o1 = {v1[0] * bf_lo(g.z), v1[1] * bf_hi(g.z), v1[2] * bf_lo(g.w), v1[3] * bf_hi(g.w)};
                    *(u32x4*)(t + ro + bj * 128) = pack8(o0, o1); } }
    }
};
struct EpiOut {
    static constexpr bool PERM = true, AFTER_DRAIN = false; static constexpr int HOOK_T = -1;
    const float *xp, *xs; u16* dst;
    __device__ __forceinline__ void operator()(const f32x4 (&acc)[2][2][4][2], const Unit& u, int wr, int wc, int fr, int fq) const {
        const int row0 = u.pm * 256 + wr * 64 + fr, col0 = u.pn * 256 + wc * 32 + 8 * fq;
#pragma unroll
        for (int ai = 0; ai < 2; ++ai)
#pragma unroll
            for (int m = 0; m < 4; ++m) { const int row = row0 + ai * 128 + m * 16; const float* xr = row < MP ? xp + (size_t)row * 2048 : xs + (size_t)(row - MP) * 2048;
#pragma unroll
                for (int bj = 0; bj < 2; ++bj) { const int c = col0 + bj * 128; const f32x4 x0 = *(const f32x4*)(xr + c), x1 = *(const f32x4*)(xr + c + 4);
                    *(u32x4*)(dst + (size_t)row * 2048 + c) = pack8(x0 * DN_ALPHA + acc[ai][bj][m][0], x1 * DN_ALPHA + acc[ai][bj][m][1]); } }
    }
};
struct EpiDown {
    static constexpr bool PERM = true, AFTER_DRAIN = false; static constexpr int HOOK_T = -1;
    const u16* hb; u16* dst;
    __device__ __forceinline__ void operator()(const f32x4 (&acc)[2][2][4][2], const Unit& u, int wr, int wc, int fr, int fq) const {
        const int row0 = u.pm * 256 + wr * 64 + fr, col0 = u.pn * 256 + wc * 32 + 8 * fq;
#pragma unroll
        for (int ai = 0; ai < 2; ++ai)
#pragma unroll
            for (int m = 0; m < 4; ++m) { const size_t ro = (size_t)(row0 + ai * 128 + m * 16) * 2048 + col0;
#pragma unroll
                for (int bj = 0; bj < 2; ++bj) { const u32x4 hv = *(const u32x4*)(hb + ro + bj * 128);
                    const f32x4 h0 = {bf_lo(hv.x), bf_hi(hv.x), bf_lo(hv.y), bf_hi(hv.y)}, h1 = {bf_lo(hv.z), bf_hi(hv.z), bf_lo(hv.w), bf_hi(hv.w)};
                    *(u32x4*)(dst + ro + bj * 128) = pack8(h0 * DN_ALPHA + acc[ai][bj][m][0], h1 * DN_ALPHA + acc[ai][bj][m][1]); } }
    }
};
struct EpiUp {
    static constexpr bool PERM = true, AFTER_DRAIN = false; static constexpr int HOOK_T = -1;
    const float *conv_w, *conv_b, *state_conv; float* out; u16* a; float *uh, *uf, *gf;
    __device__ __forceinline__ void operator()(const f32x4 (&acc)[2][2][4][2], const Unit& u, int wr, int wc, int fr, int fq) const {
        const int lane = fq * 16 + fr, ch = u.pn * 128 + wc * 32 + 8 * fq;
        const int src1 = (lane & 48) | ((fr + 15) & 15), src2 = (lane & 48) | ((fr + 14) & 15);
        f32x4 w0[2], w1[2], w2[2], cb[2];
#pragma unroll
        for (int n = 0; n < 2; ++n) { w0[n] = *(const f32x4*)(conv_w + ch + 4 * n); w1[n] = *(const f32x4*)(conv_w + DFF + ch + 4 * n); w2[n] = *(const f32x4*)(conv_w + 2 * DFF + ch + 4 * n); cb[n] = *(const f32x4*)(conv_b + ch + 4 * n); }
        const bool prompt = u.pm < 128;
#pragma unroll
        for (int ai = 0; ai < 2; ++ai) {
            const int seg = u.pm * 4 + ai * 2 + wr;
#pragma unroll
            for (int m = 0; m < 4; ++m) {
                const int row = seg * 64 + m * 16 + fr;
                f32x4 p1[2], p2[2];
#pragma unroll
                for (int n = 0; n < 2; ++n)
#pragma unroll
                    for (int j = 0; j < 4; ++j) {
                        const float cur = acc[ai][0][m][n][j], prv = m > 0 ? acc[ai][0][m > 0 ? m - 1 : 0][n][j] : 0.f;
                        p1[n][j] = __int_as_float(__builtin_amdgcn_update_dpp(0, __float_as_int(fr == 15 ? prv : cur), 0x121, 0xf, 0xf, false));
                        p2[n][j] = __int_as_float(__builtin_amdgcn_update_dpp(0, __float_as_int(fr >= 14 ? prv : cur), 0x122, 0xf, 0xf, false)); }
                bool fix = false;
                if (prompt) {
                    const int t = row & 2047, b = row >> 11;
                    if (m == 0 && fr < 2) { fix = true; float* d = uf + ((size_t)seg * 2 + fr) * DFF + ch; float* e = gf + ((size_t)seg * 2 + fr) * DFF + ch;
                        *(f32x4*)d = acc[ai][0][m][0]; *(f32x4*)(d + 4) = acc[ai][0][m][1]; *(f32x4*)e = acc[ai][1][m][0]; *(f32x4*)(e + 4) = acc[ai][1][m][1]; }
                    if (m == 3 && fr >= 14) { float* d = uh + ((size_t)seg * 2 + (fr - 14)) * DFF + ch; *(f32x4*)d = acc[ai][0][m][0]; *(f32x4*)(d + 4) = acc[ai][0][m][1]; }
                    if (t >= 2046) { float* d = out + O_CP + ((size_t)b * 2 + (t - 2046)) * DFF + ch; *(f32x4*)d = acc[ai][0][m][0]; *(f32x4*)(d + 4) = acc[ai][0][m][1]; }
                } else {
                    const int rs = row - MP, ts = rs & 31, bs = rs >> 5;
                    if (ts < 2) { const float* s1 = state_conv + ((size_t)bs * 2 + 1) * DFF + ch; const float* s0 = state_conv + ((size_t)bs * 2) * DFF + ch;
                        const f32x4 a1 = *(const f32x4*)s1, b1 = *(const f32x4*)(s1 + 4), a0 = *(const f32x4*)s0, b0 = *(const f32x4*)(s0 + 4);
                        if (ts == 0) { p1[0] = a1; p1[1] = b1; p2[0] = a0; p2[1] = b0; } else { p2[0] = a1; p2[1] = b1; } }
                    if (ts >= 30) { float* d = out + O_CS + ((size_t)bs * 2 + (ts - 30)) * DFF + ch; *(f32x4*)d = acc[ai][0][m][0]; *(f32x4*)(d + 4) = acc[ai][0][m][1]; }
                }
                if (!fix) {
                    f32x4 r[2];
#pragma unroll
                    for (int n = 0; n < 2; ++n)
#pragma unroll
                        for (int j = 0; j < 4; ++j) { const float uc = cb[n][j] + w0[n][j] * p2[n][j] + w1[n][j] * p1[n][j] + w2[n][j] * acc[ai][0][m][n][j]; r[n][j] = gelu_tanh(uc) * acc[ai][1][m][n][j]; }
                    __builtin_nontemporal_store(pack8(r[0], r[1]), (u32x4*)(a + (size_t)row * DFF + ch));
                }
            }
        }
    }
};

__device__ __forceinline__ void phase_fixup(const Params& p) {
    const float* uh = (const float*)(p.ws + R_SIDE); const float* uf = uh + SZ_SIDE / 4; const float* gf = uf + SZ_SIDE / 4; u16* a = (u16*)(p.ws + R_AACT);
    const int total = 512 * 2 * DFF;
    for (int i = blockIdx.x * 512 + threadIdx.x; i < total; i += gridDim.x * 512) {
        const int ch = i % DFF, sj = i / DFF, j = sj & 1, seg = sj >> 1, row = seg * 64 + j, t = row & 2047;
        const float u0 = uf[((size_t)seg * 2 + j) * DFF + ch], g0 = gf[((size_t)seg * 2 + j) * DFF + ch];
        float p1, p2;
        if (j == 0) { p1 = t == 0 ? 0.f : uh[((size_t)(seg - 1) * 2 + 1) * DFF + ch]; p2 = t == 0 ? 0.f : uh[((size_t)(seg - 1) * 2) * DFF + ch]; }
        else { p1 = uf[((size_t)seg * 2) * DFF + ch]; p2 = t == 1 ? 0.f : uh[((size_t)(seg - 1) * 2 + 1) * DFF + ch]; }
        const float uc = p.conv_b[ch] + p.conv_w[ch] * p2 + p.conv_w[DFF + ch] * p1 + p.conv_w[2 * DFF + ch] * u0;
        a[(size_t)row * DFF + ch] = f2bf(gelu_tanh(uc) * g0);
    }
}

__device__ __forceinline__ float logsig(float x) { return fminf(x, 0.f) - __logf(1.f + __expf(-fabsf(x))); }

__device__ __forceinline__ void gla_prep_unit(LAS unsigned char* lds, const Params& p, int pu, float (&gu0)[16], float (&gu1)[16], float& gb0, float& gb1, int& hcur, bool dry = false) {
    const int tid = opaque_tid();
    int b, h, r0, valid, brow;
    if (pu < 2048) { h = pu & 3; const int n = (pu >> 2) & 31; b = pu >> 7; r0 = b * 2048 + 64 * n; valid = 64; brow = b * 32 + n; }
    else { const int ps = pu - 2048; h = ps & 3; b = ps >> 2; r0 = MP + 32 * b; valid = 32; brow = 512 + b; }
    LAS float* ALO = (LAS float*)(lds); LAS float* CS = (LAS float*)(lds + 4096);
    u16* qg = (u16*)(p.ws + R_QG); u16* kg = (u16*)(p.ws + R_KG); const float* alo = (const float*)(p.ws + R_ALO); float* decb = (float*)(p.ws + R_DEC);
    const int kc = tid & 127, rg = tid >> 7;
    if (h != hcur) { hcur = h;
#pragma unroll
        for (int i = 0; i < 16; ++i) { gu0[i] = p.gate_up[i * 1024 + h * 256 + 2 * kc]; gu1[i] = p.gate_up[i * 1024 + h * 256 + 2 * kc + 1]; }
        gb0 = p.gate_b[h * 256 + 2 * kc]; gb1 = p.gate_b[h * 256 + 2 * kc + 1]; }
    if (tid < 256) { const int t = tid >> 2, c4 = tid & 3; const int row = min(r0 + t, M - 1); *(LAS f32x4*)(ALO + t * 16 + 4 * c4) = *(const f32x4*)(alo + (size_t)row * 16 + 4 * c4); }
    __syncthreads();
    float la0[16], la1[16]; float run0 = 0.f, run1 = 0.f;
#pragma unroll
    for (int rr = 0; rr < 16; ++rr) { const int t = 16 * rg + rr; float x0 = gb0, x1 = gb1;
#pragma unroll
        for (int i4 = 0; i4 < 4; ++i4) { const f32x4 a = *(const LAS f32x4*)(ALO + t * 16 + 4 * i4);
#pragma unroll
            for (int e = 0; e < 4; ++e) { x0 += a[e] * gu0[4 * i4 + e]; x1 += a[e] * gu1[4 * i4 + e]; } }
        if (t < valid) { run0 += logsig(x0) * 0.0625f; run1 += logsig(x1) * 0.0625f; }
        la0[rr] = run0; la1[rr] = run1; }
    CS[rg * 256 + 2 * kc] = run0; CS[rg * 256 + 2 * kc + 1] = run1;
    __syncthreads();
    float pre0 = 0.f, pre1 = 0.f, tot0 = 0.f, tot1 = 0.f;
#pragma unroll
    for (int g = 0; g < 4; ++g) { const float c0 = CS[g * 256 + 2 * kc], c1 = CS[g * 256 + 2 * kc + 1]; tot0 += c0; tot1 += c1; if (g < rg) { pre0 += c0; pre1 += c1; } }
    if (rg == 0) { decb[(size_t)brow * 1024 + h * 256 + 2 * kc] = __expf(tot0); decb[(size_t)brow * 1024 + h * 256 + 2 * kc + 1] = __expf(tot1); }
#pragma unroll
    for (int rr = 0; rr < 16; ++rr) { const int t = 16 * rg + rr;
        if (t < valid) { const size_t o = (size_t)(r0 + t) * 1024 + h * 256 + 2 * kc; const unsigned qr = *(const unsigned*)(qg + o), kr = *(const unsigned*)(kg + o);
            const float b0 = la0[rr] + pre0, b1 = la1[rr] + pre1;
            u16* qd = dry ? (u16*)p.out : qg; u16* kd = dry ? (u16*)p.out + (size_t)M * 1024 : kg;
            *(unsigned*)(qd + o) = cvt_pk_bf16(bf_lo(qr) * 0.0625f * __expf(b0), bf_hi(qr) * 0.0625f * __expf(b1));
            *(unsigned*)(kd + o) = cvt_pk_bf16(bf_lo(kr) * __expf(-b0), bf_hi(kr) * __expf(-b1)); } }
    __syncthreads();
}

__device__ __forceinline__ void gla_unit(LAS unsigned char* lds, const Params& p, int u) {
    const int tid = opaque_tid(), lane = tid & 63, w = __builtin_amdgcn_readfirstlane(tid >> 6), r = lane & 15, q = lane >> 4;
    const bool smp = u >= 256; const int uu = smp ? u - 256 : u;
    const int b = uu >> 4, h = (uu >> 2) & 3, vs = uu & 3;
    const int row_base = smp ? MP + b * 32 : b * 2048, nblk = smp ? 1 : 32, valid = smp ? 32 : 64;
    LAS u16* QT = (LAS u16*)(lds); LAS u16* KT = (LAS u16*)(lds + 33792); LAS u16* KTT = (LAS u16*)(lds + 67584); LAS u16* VT = (LAS u16*)(lds + 104448); LAS u16* PP = (LAS u16*)(lds + 122880);
    LAS float* DEC = (LAS float*)(lds + 140288);
    const u16* qg = (const u16*)(p.ws + R_QG); const u16* kg = (const u16*)(p.ws + R_KG); const u16* vg = (const u16*)(p.ws + R_VG); const float* decb = (const float*)(p.ws + R_DEC);
    u16* og = (u16*)p.out + 1024;
    f32x4 S[16];
    const size_t sbase_u = ((size_t)(b * 4 + h) * 256) * 512 + vs * 128 + 16 * w;
    const int soff = 4 * q * 512 + r;
#pragma unroll
    for (int i = 0; i < 16; ++i) {
#pragma unroll
        for (int j = 0; j < 4; ++j) S[i][j] = smp ? (p.state_gla + sbase_u)[soff + (16 * i + j) * 512] : 0.f;
        __builtin_amdgcn_sched_barrier(0); }
    u32x4 pv[2], pq[4], pk[4]; f32x4 pdec = {0.f, 0.f, 0.f, 0.f};
#define GLA_LOAD(nn) do { const int r0_ = row_base + 64 * (nn), brow_ = smp ? 512 + b : b * 32 + (nn); \
        if (tid < 64) pdec = *(const f32x4*)(decb + (size_t)brow_ * 1024 + h * 256 + 4 * tid); \
        _Pragma("unroll") for (int i = 0; i < 2; ++i) { const int id = tid + 512 * i, s_ = id & 63, c8 = id >> 6; pv[i] = (u32x4){0u, 0u, 0u, 0u}; \
            if (s_ < valid) pv[i] = *(const u32x4*)(vg + (size_t)(r0_ + s_) * 2048 + h * 512 + vs * 128 + 8 * c8); } \
        _Pragma("unroll") for (int i = 0; i < 4; ++i) { const int id = tid + 512 * i, s_ = id & 63, c8 = id >> 6; pq[i] = (u32x4){0u, 0u, 0u, 0u}; pk[i] = (u32x4){0u, 0u, 0u, 0u}; \
            if (s_ < valid) { const size_t o_ = (size_t)(r0_ + s_) * 1024 + h * 256 + 8 * c8; pq[i] = *(const u32x4*)(qg + o_); pk[i] = *(const u32x4*)(kg + o_); } } } while (0)
    GLA_LOAD(0);
    for (int n = 0; n < nblk; ++n) {
        const int r0 = row_base + 64 * n;
        if (tid < 64) *(LAS f32x4*)(DEC + 4 * tid) = pdec;
#pragma unroll
        for (int i = 0; i < 2; ++i) { const int id = tid + 512 * i, s = id & 63, c8 = id >> 6; const u32x4 v = pv[i];
#pragma unroll
            for (int jj = 0; jj < 4; ++jj) { VT[(8 * c8 + 2 * jj) * 72 + s] = (u16)(v[jj] & 0xffffu); VT[(8 * c8 + 2 * jj + 1) * 72 + s] = (u16)(v[jj] >> 16); } }
#pragma unroll
        for (int i = 0; i < 4; ++i) { const int id = tid + 512 * i, s = id & 63, c8 = id >> 6; const u32x4 qv = pq[i], kv = pk[i];
            *(LAS u32x4*)(QT + s * 264 + 8 * c8) = qv; *(LAS u32x4*)(KT + s * 264 + 8 * c8) = kv;
#pragma unroll
            for (int jj = 0; jj < 4; ++jj) { KTT[(8 * c8 + 2 * jj) * 72 + s] = (u16)(kv[jj] & 0xffffu); KTT[(8 * c8 + 2 * jj + 1) * 72 + s] = (u16)(kv[jj] >> 16); } }
        __syncthreads();
        if (n + 1 < nblk) GLA_LOAD(n + 1);
        { const int mt = w >> 1;
#pragma unroll
          for (int tt = 0; tt < 2; ++tt) { const int nt = 2 * (w & 1) + tt; f32x4 c = {0.f, 0.f, 0.f, 0.f};
              if (nt <= mt) { bf16x8 fa[8], fb[8];
#pragma unroll
                  for (int ks = 0; ks < 8; ++ks) { fa[ks] = *(const LAS bf16x8*)(QT + (16 * mt + r) * 264 + 32 * ks + 8 * q); fb[ks] = *(const LAS bf16x8*)(KT + (16 * nt + r) * 264 + 32 * ks + 8 * q); }
                  __builtin_amdgcn_sched_barrier(0);
#pragma unroll
                  for (int ks = 0; ks < 8; ++ks) c = mfma16(fa[ks], fb[ks], c); }
#pragma unroll
              for (int j = 0; j < 4; ++j) { const int t = 16 * mt + 4 * q + j, s = 16 * nt + r; PP[t * 72 + s] = f2bf(s <= t ? c[j] : 0.f); } } }
        f32x4 oacc[4];
#pragma unroll
        for (int mt = 0; mt < 4; ++mt) oacc[mt] = (f32x4){0.f, 0.f, 0.f, 0.f};
#pragma unroll
        for (int p2 = 0; p2 < 4; ++p2) { u32x2 a0[2][4], a1[2][4];
#pragma unroll
            for (int e = 0; e < 2; ++e)
#pragma unroll
                for (int mt = 0; mt < 4; ++mt) { const int pp = 2 * p2 + e; a0[e][mt] = *(const LAS u32x2*)(QT + (16 * mt + r) * 264 + 32 * pp + 4 * q); a1[e][mt] = *(const LAS u32x2*)(QT + (16 * mt + r) * 264 + 32 * pp + 16 + 4 * q); }
            __builtin_amdgcn_sched_barrier(0);
#pragma unroll
            for (int e = 0; e < 2; ++e) { const int pp = 2 * p2 + e;
                u32x4 bw; bw.x = cvt_pk_bf16(S[2 * pp][0], S[2 * pp][1]); bw.y = cvt_pk_bf16(S[2 * pp][2], S[2 * pp][3]); bw.z = cvt_pk_bf16(S[2 * pp + 1][0], S[2 * pp + 1][1]); bw.w = cvt_pk_bf16(S[2 * pp + 1][2], S[2 * pp + 1][3]);
#pragma unroll
                for (int mt = 0; mt < 4; ++mt) { const u32x4 aw = {a0[e][mt].x, a0[e][mt].y, a1[e][mt].x, a1[e][mt].y}; oacc[mt] = mfma16(as_bf8(aw), as_bf8(bw), oacc[mt]); } }
            __builtin_amdgcn_sched_barrier(0); }
        __syncthreads();
        bf16x8 bv[2];
        { bf16x8 pa[4][2];
#pragma unroll
          for (int ks = 0; ks < 2; ++ks) bv[ks] = *(const LAS bf16x8*)(VT + (16 * w + r) * 72 + 32 * ks + 8 * q);
#pragma unroll
          for (int mt = 0; mt < 4; ++mt)
#pragma unroll
              for (int ks = 0; ks < 2; ++ks) pa[mt][ks] = *(const LAS bf16x8*)(PP + (16 * mt + r) * 72 + 32 * ks + 8 * q);
          __builtin_amdgcn_sched_barrier(0);
#pragma unroll
          for (int mt = 0; mt < 4; ++mt) {
#pragma unroll
              for (int ks = 0; ks < 2; ++ks) oacc[mt] = mfma16(pa[mt][ks], bv[ks], oacc[mt]); } }
#pragma unroll
        for (int mt = 0; mt < 4; ++mt)
#pragma unroll
            for (int j = 0; j < 4; ++j) { const int t = 16 * mt + 4 * q + j; if (t < valid) og[(size_t)(r0 + t) * 3072 + h * 512 + vs * 128 + 16 * w + r] = f2bf(oacc[mt][j]); }
#pragma unroll
        for (int g = 0; g < 4; ++g) { bf16x8 ka[4][2]; f32x4 dd[4];
#pragma unroll
            for (int e = 0; e < 4; ++e) { const int i = 4 * g + e;
#pragma unroll
                for (int ks = 0; ks < 2; ++ks) ka[e][ks] = *(const LAS bf16x8*)(KTT + (16 * i + r) * 72 + 32 * ks + 8 * q);
                dd[e] = *(const LAS f32x4*)(DEC + 16 * i + 4 * q); }
            __builtin_amdgcn_sched_barrier(0);
#pragma unroll
            for (int e = 0; e < 4; ++e) { const int i = 4 * g + e;
#pragma unroll
                for (int ks = 0; ks < 2; ++ks) S[i] = mfma16(ka[e][ks], bv[ks], S[i]); }
#pragma unroll
            for (int e = 0; e < 4; ++e) { const int i = 4 * g + e; S[i] = S[i] * dd[e]; }
            __builtin_amdgcn_sched_barrier(0); }
        __syncthreads();
    }
    float* so = p.out + (smp ? O_SS : O_SP);
#pragma unroll
    for (int i = 0; i < 16; ++i) {
#pragma unroll
        for (int j = 0; j < 4; ++j) (so + sbase_u)[soff + (16 * i + j) * 512] = S[i][j];
        __builtin_amdgcn_sched_barrier(0); }
}

#undef GLA_LOAD
template <bool smp>
__device__ __forceinline__ void attn_unit(LAS unsigned char* lds, const Params& p, int u, int& hprev, bool dry = false) {
    const int tid = opaque_tid(), lane = tid & 63, w = __builtin_amdgcn_readfirstlane(tid >> 6), r = lane & 15, q = lane >> 4;
    LAS u16* PL = (LAS u16*)lds; LAS float* RED = (LAS float*)(lds + 76800); LAS float* LS = RED + 512; LAS float* BT = LS + 512;
    int b, h, c = 0, nkc = 9, NT, rq0;
    if (!smp) { c = u & 31; h = (u >> 5) & 7; b = u >> 8; nkc = min(c, 8) + 1; NT = 4 * nkc; rq0 = b * 2048 + c * 64; }
    else { const int us = u - 4096; h = us & 7; b = us >> 3; NT = 34; rq0 = MP + b * 32; }
    const int tk0 = smp ? 0 : (c - (nkc - 1)) * 64;
    u16* qa = (u16*)(p.ws + R_QA); u16* oa = (u16*)p.out; (void)dry; const u16* kab = (const u16*)(p.ws + R_KA); const u16* vat = (const u16*)(p.ws + R_VAT);
    const float* ksn = p.out + O_KS; const float* vsn = p.out + O_VS;
    if (h != hprev) { __syncthreads(); if (tid < 257) BT[tid] = p.rel_bias[h * 257 + tid]; hprev = h; __syncthreads(); }
    LAS u16* QL = (LAS u16*)(lds + 82944);
#pragma unroll
    for (int i = 0; i < 2; ++i) { const int id = tid + 512 * i, row = id >> 4, c8 = id & 15; const int qrow = min(rq0 + row, M - 1);
        *(LAS u32x4*)(QL + row * 136 + 8 * c8) = *(const u32x4*)(qa + (size_t)qrow * 1024 + h * 128 + 8 * c8); }
    f32x4 sc[5][4];
#define ATT_KLOAD(dst, ii) do { const int ktc_ = min(w + 8 * (ii), NT - 1); \
        if (!smp) { const u16* kp_ = kab + (size_t)(b * 2048 + tk0 + 16 * ktc_ + r) * 1024 + h * 128 + 8 * q; \
            _Pragma("unroll") for (int ks = 0; ks < 4; ++ks) dst[ks] = *(const bf16x8*)(kp_ + 32 * ks); } \
        else { const int key_ = 16 * ktc_ + r; const float* kp_ = (key_ < 512 ? p.cache_k + ((size_t)(b * 512 + key_) * 8 + h) * 128 : ksn + ((size_t)(b * 32 + key_ - 512) * 8 + h) * 128) + 8 * q; \
            _Pragma("unroll") for (int ks = 0; ks < 4; ++ks) { const f32x4 x0_ = *(const f32x4*)(kp_ + 32 * ks), x1_ = *(const f32x4*)(kp_ + 32 * ks + 4); dst[ks] = as_bf8(pack8(x0_, x1_)); } } } while (0)
    bf16x8 kf[4], kn[4];
    ATT_KLOAD(kf, 0);
    __syncthreads();
#pragma unroll
    for (int i = 0; i < 5; ++i) { const int kt = w + 8 * i;
        const float neg = kt < NT ? 0.f : -1e30f;
        if (i < 4) ATT_KLOAD(kn, i + 1);
        f32x4 ca[4]; float bt[4][4];
#pragma unroll
        for (int rt = 0; rt < 4; ++rt) { ca[rt] = (f32x4){0.f, 0.f, 0.f, 0.f};
#pragma unroll
            for (int j = 0; j < 4; ++j) { const int qi = 16 * rt + 4 * q + j, key = 16 * kt + r; int rel = smp ? 512 + qi - key : qi - (key - 64 * (nkc - 1)); rel = max(-128, min(128, rel)); bt[rt][j] = BT[rel + 128]; } }
#pragma unroll
        for (int ks = 0; ks < 4; ++ks) { bf16x8 qfr[4];
#pragma unroll
            for (int rt = 0; rt < 4; ++rt) qfr[rt] = *(const LAS bf16x8*)(QL + (16 * rt + r) * 136 + 32 * ks + 8 * q);
            __builtin_amdgcn_sched_barrier(0);
#pragma unroll
            for (int rt = 0; rt < 4; ++rt) ca[rt] = mfma16(qfr[rt], kf[ks], ca[rt]); }
#pragma unroll
        for (int rt = 0; rt < 4; ++rt)
#pragma unroll
            for (int j = 0; j < 4; ++j) sc[i][rt][j] = ca[rt][j] * 0.08838834764831845f + bt[rt][j] + neg;
        __builtin_amdgcn_sched_barrier(0);
#pragma unroll
        for (int ks = 0; ks < 4; ++ks) kf[ks] = kn[ks]; }
#undef ATT_KLOAD
#pragma unroll
    for (int rt = 0; rt < 4; ++rt)
#pragma unroll
        for (int j = 0; j < 4; ++j) { float m = sc[0][rt][j];
#pragma unroll
            for (int i = 1; i < 5; ++i) m = fmaxf(m, sc[i][rt][j]);
#pragma unroll
            for (int o = 1; o < 16; o <<= 1) m = fmaxf(m, __shfl_xor(m, o));
            if (r == 0) RED[(16 * rt + 4 * q + j) * 8 + w] = m; }
    __syncthreads();
    float mrow[4][4], srow[4][4];
#pragma unroll
    for (int rt = 0; rt < 4; ++rt)
#pragma unroll
        for (int j = 0; j < 4; ++j) { const int row = 16 * rt + 4 * q + j; const f32x4 m0 = *(const LAS f32x4*)(RED + row * 8), m1 = *(const LAS f32x4*)(RED + row * 8 + 4);
            mrow[rt][j] = fmaxf(fmaxf(fmaxf(m0[0], m0[1]), fmaxf(m0[2], m0[3])), fmaxf(fmaxf(m1[0], m1[1]), fmaxf(m1[2], m1[3]))); srow[rt][j] = 0.f; }
#pragma unroll
    for (int i = 0; i < 5; ++i) { const int kt = w + 8 * i;
        if (kt < NT) {
#pragma unroll
            for (int rt = 0; rt < 4; ++rt)
#pragma unroll
                for (int j = 0; j < 4; ++j) { const float pv = __expf(sc[i][rt][j] - mrow[rt][j]); srow[rt][j] += pv; PL[(16 * rt + 4 * q + j) * 600 + 16 * kt + r] = f2bf(pv); } } }
#pragma unroll
    for (int rt = 0; rt < 4; ++rt)
#pragma unroll
        for (int j = 0; j < 4; ++j) { float sv = srow[rt][j];
#pragma unroll
            for (int o = 1; o < 16; o <<= 1) sv += __shfl_xor(sv, o);
            if (r == 0) LS[(16 * rt + 4 * q + j) * 8 + w] = sv; }
    __syncthreads();
    f32x4 o[4];
#pragma unroll
    for (int rt = 0; rt < 4; ++rt) o[rt] = (f32x4){0.f, 0.f, 0.f, 0.f};
    const int d = 16 * w + r;
    const int nks = NT / 2;
#pragma unroll
    for (int g = 0; g < 3; ++g) {
        if (6 * g < nks) {
            bf16x8 vb[6];
#pragma unroll
            for (int e = 0; e < 6; ++e) { const int ks = min(6 * g + e, nks - 1);
                if (!smp) vb[e] = *(const bf16x8*)(vat + ((size_t)((b * 8 + h) * 128 + d)) * 2048 + tk0 + 32 * ks + 8 * q);
                else { const int key0 = 32 * ks + 8 * q; const float* vp = key0 < 512 ? p.cache_v + ((size_t)(b * 512 + key0) * 8 + h) * 128 + d : vsn + ((size_t)(b * 32 + key0 - 512) * 8 + h) * 128 + d;
                    f32x4 x0, x1;
#pragma unroll
                    for (int e2 = 0; e2 < 4; ++e2) { x0[e2] = vp[(size_t)e2 * 1024]; x1[e2] = vp[(size_t)(e2 + 4) * 1024]; }
                    vb[e] = as_bf8(pack8(x0, x1)); } }
#pragma unroll
            for (int e = 0; e < 6; ++e) { const int ks = 6 * g + e;
                if (ks < nks) {
#pragma unroll
                    for (int rt = 0; rt < 4; ++rt) { const bf16x8 a = *(const LAS bf16x8*)(PL + (16 * rt + r) * 600 + 32 * ks + 8 * q); o[rt] = mfma16(a, vb[e], o[rt]); } } } } }
#pragma unroll
    for (int rt = 0; rt < 4; ++rt)
#pragma unroll
        for (int j = 0; j < 4; ++j) { const int row = 16 * rt + 4 * q + j; const f32x4 l0 = *(const LAS f32x4*)(LS + row * 8), l1 = *(const LAS f32x4*)(LS + row * 8 + 4);
            const float inv = __builtin_amdgcn_rcpf(((l0[0] + l0[1]) + (l0[2] + l0[3])) + ((l1[0] + l1[1]) + (l1[2] + l1[3])));
            if (!smp || row < 32) oa[(size_t)(rq0 + row) * 3072 + h * 128 + d] = f2bf(o[rt][j] * inv); }
    __syncthreads();
}

__device__ __forceinline__ void phase_normgate(const Params& p) {
    const int lane = threadIdx.x & 63, gw = blockIdx.x * 8 + (threadIdx.x >> 6), NGW = gridDim.x * 8;
    u16* og = (u16*)p.out + 1024; const u16* rgb = (const u16*)(p.ws + R_RG);
#pragma unroll 2
    for (int it = gw; it < M * 4; it += NGW) { const int row = it >> 2, h = it & 3; const size_t o = (size_t)row * 3072 + h * 512 + 8 * lane, orr = (size_t)row * 2048 + h * 512 + 8 * lane;
        const u32x4 ov = *(const u32x4*)(og + o), rv = *(const u32x4*)(rgb + orr);
        float v[8] = {bf_lo(ov.x), bf_hi(ov.x), bf_lo(ov.y), bf_hi(ov.y), bf_lo(ov.z), bf_hi(ov.z), bf_lo(ov.w), bf_hi(ov.w)};
        float rr[8] = {bf_lo(rv.x), bf_hi(rv.x), bf_lo(rv.y), bf_hi(rv.y), bf_lo(rv.z), bf_hi(rv.z), bf_lo(rv.w), bf_hi(rv.w)};
        float ss = 0.f;
#pragma unroll
        for (int e = 0; e < 8; ++e) ss += v[e] * v[e];
        const float rstd = rsqrtf(wave_sum(ss) * (1.f / 512.f) + 1e-6f);
        const f32x4 g0 = *(const f32x4*)(p.norm_g + h * 512 + 8 * lane), g1 = *(const f32x4*)(p.norm_g + h * 512 + 8 * lane + 4);
        float res[8];
#pragma unroll
        for (int e = 0; e < 8; ++e) { const float g = e < 4 ? g0[e] : g1[e - 4]; res[e] = v[e] * rstd * g * (rr[e] * __builtin_amdgcn_rcpf(1.f + __expf(-rr[e]))); }
        u32x4 w; w.x = cvt_pk_bf16(res[0], res[1]); w.y = cvt_pk_bf16(res[2], res[3]); w.z = cvt_pk_bf16(res[4], res[5]); w.w = cvt_pk_bf16(res[6], res[7]);
        *(u32x4*)(og + o) = w; }
}
template <bool TO_BF16, bool SRC_BF16>
__device__ __forceinline__ void phase_ln(const float* src, const u16* srcb, const float* g, const float* bta, u16* dstb, float* dstf) {
    const int lane = threadIdx.x & 63, gw = blockIdx.x * 8 + (threadIdx.x >> 6), NGW = gridDim.x * 8;
#pragma unroll 2
    for (int row = gw; row < M; row += NGW) { const float* s = src + (size_t)row * 2048;
        f32x4 v[8]; float sum = 0.f;
#pragma unroll
        for (int j = 0; j < 8; ++j) { if (SRC_BF16) { const u32x2 wv = *(const u32x2*)(srcb + (size_t)row * 2048 + (j * 64 + lane) * 4); v[j] = (f32x4){bf_lo(wv.x), bf_hi(wv.x), bf_lo(wv.y), bf_hi(wv.y)}; } else v[j] = *(const f32x4*)(s + (j * 64 + lane) * 4);
            sum += (v[j][0] + v[j][1]) + (v[j][2] + v[j][3]); }
        const float mean = wave_sum(sum) * (1.f / 2048.f); float s2 = 0.f;
#pragma unroll
        for (int j = 0; j < 8; ++j) { v[j] = v[j] - mean; s2 += (v[j][0] * v[j][0] + v[j][1] * v[j][1]) + (v[j][2] * v[j][2] + v[j][3] * v[j][3]); }
        const float rstd = rsqrtf(wave_sum(s2) * (1.f / 2048.f) + 1e-5f);
#pragma unroll
        for (int j = 0; j < 8; ++j) { const int c = (j * 64 + lane) * 4; const f32x4 gg = *(const f32x4*)(g + c), bb = *(const f32x4*)(bta + c); const f32x4 y = v[j] * rstd * gg + bb;
            if (TO_BF16) { u32x2 w; w.x = cvt_pk_bf16(y[0], y[1]); w.y = cvt_pk_bf16(y[2], y[3]); *(u32x2*)(dstb + (size_t)row * 2048 + c) = w; }
            else *(f32x4*)(dstf + (size_t)row * 2048 + c) = y; } }
}

template <class Epi>
__device__ __forceinline__ void run_gemm(LAS unsigned char* lds, const u16* A, const u16* Bt, int N, int K, const Epi& E) {
    pg8::Gemm g; g.A = A; g.Bt = Bt; g.M = M; g.N = N; g.K = K;
    pg8::StaticOrder S; S.init(M, N, (int)gridDim.x, (int)blockIdx.x);
    pg8::gemm_phase<Epi, pg8::StaticOrder, false>(lds, g, S, E, nullptr);
}

__device__ __forceinline__ void gsync(cg::grid_group& g) { asm volatile("s_waitcnt vmcnt(0) lgkmcnt(0)" ::: "memory"); g.sync(); asm volatile("" ::: "memory"); }

__global__ __launch_bounds__(512, 2) void fwd_megakernel(Params p) {
    extern __shared__ __attribute__((aligned(16))) unsigned char shm[];
    LAS unsigned char* lds = (LAS unsigned char*)shm;
    cg::grid_group grid = cg::this_grid();
    unsigned char* ws = p.ws;
    phase0(lds, p);
#ifdef PROBE_P02
    phase0(lds, p);
#endif
    gsync(grid);
#if defined(STOP_AFTER) && STOP_AFTER == 1
    return;
#endif
#ifndef SKIP_Z
    { EpiZ E; E.ws = ws; E.out = p.out; E.merge_b = p.merge_b; run_gemm(lds, (const u16*)p.out, (const u16*)(ws + W_IN), ZN, 2048, E);
      { const int nunits = (M / 256) * (ZN / 256), full = nunits % (int)gridDim.x;
        if (full == 0) phase0_rest(lds, p, (int)blockIdx.x, (int)gridDim.x);
        else if ((int)blockIdx.x >= full) phase0_rest(lds, p, (int)blockIdx.x - full, (int)gridDim.x - full); }
#ifdef PROBE_Z2
      run_gemm(lds, (const u16*)p.out, (const u16*)(ws + W_IN), ZN, 2048, E);
#endif
    }
#endif
    gsync(grid);
#if defined(STOP_AFTER) && STOP_AFTER == 2
    return;
#endif
    { float gu0[16], gu1[16], gb0 = 0.f, gb1 = 0.f; int hcur = -1;
      for (int pu = blockIdx.x; pu < 2176; pu += gridDim.x) gla_prep_unit(lds, p, pu, gu0, gu1, gb0, gb1, hcur); }
    { int hprev = -1;
      if (gridDim.x == 256) {
          for (int rd = 0; rd < 16; ++rd) attn_unit<false>(lds, p, ((rd * 8 + ((int)blockIdx.x & 7)) << 5) + ((((int)blockIdx.x >> 3) + 5 * rd) & 31), hprev);
      } else { for (int u = blockIdx.x; u < 4096; u += gridDim.x) attn_unit<false>(lds, p, u, hprev); }
      for (int u = 4096 + blockIdx.x; u < 4352; u += gridDim.x) attn_unit<true>(lds, p, u, hprev); }
    gsync(grid);
    for (int u = blockIdx.x; u < 768; u += gridDim.x) gla_unit(lds, p, u);
#ifdef PROBE_GLA2
    for (int u = blockIdx.x; u < 768; u += gridDim.x) gla_unit(lds, p, u);
#endif
    gsync(grid);
    phase_normgate(p);
    gsync(grid);
#if defined(STOP_AFTER) && STOP_AFTER == 4
    return;
#endif
    { EpiBr E; E.ga = (const u16*)(ws + R_MG); E.gb = (const u16*)(ws + R_MA); E.t = (u16*)(ws + R_T); run_gemm(lds, (const u16*)p.out, (const u16*)(ws + W_BRG), 2048, 3072, E); }
    gsync(grid);
#if defined(STOP_AFTER) && STOP_AFTER == 6
    return;
#endif
    { EpiOut E; E.xp = p.x_prompt; E.xs = p.x_sample; E.dst = (u16*)(ws + R_VG); run_gemm(lds, (const u16*)(ws + R_T), (const u16*)(ws + W_OUT), 2048, 2048, E); }
    gsync(grid);
#if defined(STOP_AFTER) && STOP_AFTER == 7
    return;
#endif
    phase_ln<true, true>(nullptr, (const u16*)(ws + R_VG), p.ln1_g, p.ln1_b, (u16*)(ws + R_HB), nullptr);
    gsync(grid);
#if defined(STOP_AFTER) && STOP_AFTER == 8
    return;
#endif
#ifndef SKIP_UP
    { EpiUp E; E.conv_w = p.conv_w; E.conv_b = p.conv_b; E.state_conv = p.state_conv; E.out = p.out; E.a = (u16*)(ws + R_AACT);
      E.uh = (float*)(ws + R_SIDE); E.uf = E.uh + SZ_SIDE / 4; E.gf = E.uf + SZ_SIDE / 4; run_gemm(lds, (const u16*)(ws + R_HB), (const u16*)(ws + W_UP), NUP, 2048, E);
      { const int nunits = (M / 256) * (NUP / 256), full = nunits % (int)gridDim.x;
        if (full == 0) phase0_dn(lds, p, (int)blockIdx.x, (int)gridDim.x);
        else if ((int)blockIdx.x >= full) phase0_dn(lds, p, (int)blockIdx.x - full, (int)gridDim.x - full); }
#ifdef PROBE_UP2
      run_gemm(lds, (const u16*)(ws + R_HB), (const u16*)(ws + W_UP), NUP, 2048, E);
#endif
    }
#endif
    gsync(grid);
#if defined(STOP_AFTER) && STOP_AFTER == 9
    return;
#endif
    phase_fixup(p);
    gsync(grid);
#if defined(STOP_AFTER) && STOP_AFTER == 10
    return;
#endif
    { EpiDown E; E.hb = (const u16*)(ws + R_HB); E.dst = (u16*)(ws + R_VG); run_gemm(lds, (const u16*)(ws + R_AACT), (const u16*)(ws + W_DN), 2048, DFF, E); }
    gsync(grid);
#if defined(STOP_AFTER) && STOP_AFTER == 11
    return;
#endif
    phase_ln<false, true>(nullptr, (const u16*)(ws + R_VG), p.ln2_g, p.ln2_b, nullptr, p.out);
}

extern "C" void kernel_launch(void* const* d_in, const int* in_sizes, int n_in, void* d_out, int out_size, void* d_ws, size_t ws_size, hipStream_t stream) {
    static int grid_blocks = 0;
    if (!grid_blocks) {
        if (n_in != 23 || ws_size < WS_END) { fprintf(stderr, "kernel_launch: need 23 inputs and >= %zu bytes of workspace (got %d, %zu)\n", (size_t)WS_END, n_in, ws_size); grid_blocks = -1; return; }
        int dev = 0, cus = 0, per_cu = 0;
        hipGetDevice(&dev);
        hipDeviceGetAttribute(&cus, hipDeviceAttributeMultiprocessorCount, dev);
        if (hipFuncSetAttribute((const void*)fwd_megakernel, hipFuncAttributeMaxDynamicSharedMemorySize, LDS_BYTES) != hipSuccess) { fprintf(stderr, "kernel_launch: hipFuncSetAttribute failed\n"); grid_blocks = -1; return; }
        hipOccupancyMaxActiveBlocksPerMultiprocessor(&per_cu, (const void*)fwd_megakernel, 512, LDS_BYTES);
        if (per_cu < 1) { fprintf(stderr, "kernel_launch: occupancy query says %d blocks per CU\n", per_cu); per_cu = 1; }
        (void)hipGetLastError();
        grid_blocks = cus * per_cu;
    }
    if (grid_blocks < 0) return;
    Params p{};
    const float** f = (const float**)&p;
    for (int i = 0; i < 23; ++i) f[i] = (const float*)d_in[i];
    p.out = (float*)d_out; p.ws = (unsigned char*)d_ws;
    void* args[] = {&p};
    hipError_t e = hipLaunchCooperativeKernel((const void*)fwd_megakernel, dim3(grid_blocks), dim3(512), args, LDS_BYTES, stream);
    if (e != hipSuccess) fprintf(stderr, "cooperative launch failed: %s (grid %d)\n", hipGetErrorString(e), grid_blocks);
}
```
